# Optimizing an MI355X kernel written in HIP

```python
import jax
import jax.numpy as jnp
from jax import lax
import numpy as np

D_MODEL = 1024
BATCH = 32
SEQ = 2048
DEPTH = 4

CTX_LEN = 256
GRID_W = 64
N_MIXERS = 4
MLP_HIDDEN = 4 * D_MODEL
N_MOD = 6
NORM_EPS = 1e-6
NEG_INF = -1e30

ATTN_HEADS = 16
ATTN_KV_HEADS = 4
ATTN_GROUP = ATTN_HEADS // ATTN_KV_HEADS
HEAD_DIM = D_MODEL // ATTN_HEADS
WINDOW = 128
ATTN_BLOCK = 128
ROPE_BASE = 10000.0
ROPE_AXIS_DIM = HEAD_DIM // 2
ROPE_FREQS = ROPE_AXIS_DIM // 2

GLA_HEADS = 4
GLA_KEY_DIM = D_MODEL // 2
GLA_VAL_DIM = D_MODEL
GLA_DK = GLA_KEY_DIM // GLA_HEADS
GLA_DV = GLA_VAL_DIM // GLA_HEADS
GLA_GATE_RANK = 16
GLA_TAU = 16.0
SCAN_CHUNK = 64

RWKV_HEAD_SIZE = 64
RWKV_HEADS = D_MODEL // RWKV_HEAD_SIZE
RWKV_DECAY_RANK = 64
RWKV_AAA_RANK = 64
RWKV_GATE_RANK = 128
RWKV_LN_EPS = 64e-5
L2_EPS = 1e-12

HGRN_EXPAND = 128
HGRN_HEADS = D_MODEL // HGRN_EXPAND
HGRN_FORGET_DIM = HGRN_HEADS * HGRN_EXPAND
HGRN_IN_DIM = D_MODEL // HGRN_HEADS

N_ATTN_LAYERS = (DEPTH + 3) // N_MIXERS
N_GLA_LAYERS = (DEPTH + 2) // N_MIXERS
N_RWKV_LAYERS = (DEPTH + 1) // N_MIXERS
N_HGRN_LAYERS = DEPTH // N_MIXERS

kernel_name = "hybrid_interleaved_flow_backbone"


def rms_norm(x, gain):
    xf = x.astype(jnp.float32)
    y = xf * lax.rsqrt(jnp.mean(xf * xf, axis=-1, keepdims=True) + NORM_EPS)
    return (y * gain.astype(jnp.float32)).astype(x.dtype)


def modulate(x, gain, shift, scale):
    return rms_norm(x, gain) * (1 + scale) + shift


def channel_mlp(h, w_in, w_out):
    return jnp.square(jax.nn.relu(h @ w_in)) @ w_out


def axial_rope_tables(rows):
    inv_freq = ROPE_BASE ** (-jnp.arange(ROPE_FREQS, dtype=jnp.float32) * 2.0 / ROPE_AXIS_DIM)
    pos = jnp.arange(rows * GRID_W)
    row = (pos // GRID_W).astype(jnp.float32)
    col = (pos % GRID_W).astype(jnp.float32)
    ang = jnp.stack([row[:, None] * inv_freq, col[:, None] * inv_freq], axis=1)
    return jnp.cos(ang), jnp.sin(ang)


def apply_axial_rope(x, cos, sin):
    lead = x.shape[:-1]
    xr = x.reshape(lead + (2, 2, ROPE_FREQS))
    x1, x2 = xr[..., 0, :], xr[..., 1, :]
    bshape = (1, x.shape[1]) + (1,) * (x.ndim - 3) + cos.shape[1:]
    cb = cos.reshape(bshape).astype(x.dtype)
    sb = sin.reshape(bshape).astype(x.dtype)
    out = jnp.stack([x1 * cb - x2 * sb, x2 * cb + x1 * sb], axis=-2)
    return out.reshape(x.shape)


def softmax_with_sink(s, sink):
    sk = sink.astype(jnp.float32)[None, :, :, None, None]
    m = jnp.maximum(jnp.max(s, axis=-1, keepdims=True), sk)
    e = jnp.exp(s - m)
    return e / (jnp.sum(e, axis=-1, keepdims=True) + jnp.exp(sk - m))


def windowed_gqa_sink(h_lat, h_ctx, w_qkv, w_o, sink, cos, sin, need_ctx):
    B, L, _ = h_lat.shape
    nb = L // ATTN_BLOCK
    q_cols = ATTN_HEADS * HEAD_DIM
    kv_cols = ATTN_KV_HEADS * HEAD_DIM

    def project(h):
        T = h.shape[1]
        qkv = h @ w_qkv
        q = qkv[..., :q_cols].reshape(B, T, ATTN_KV_HEADS, ATTN_GROUP, HEAD_DIM) * (HEAD_DIM ** -0.5)
        k = qkv[..., q_cols:q_cols + kv_cols].reshape(B, T, ATTN_KV_HEADS, HEAD_DIM)
        v = qkv[..., q_cols + kv_cols:].reshape(B, T, ATTN_KV_HEADS, HEAD_DIM)
        return q, k, v

    q_lat, k_lat, v_lat = project(h_lat)
    q_ctx, k_ctx, v_ctx = project(h_ctx)
    q_lat = apply_axial_rope(q_lat, cos, sin)
    k_lat = apply_axial_rope(k_lat, cos, sin)
    sink_g = sink.reshape(ATTN_KV_HEADS, ATTN_GROUP)

    def band(t):
        tp = jnp.pad(t, ((0, 0), (ATTN_BLOCK, ATTN_BLOCK), (0, 0), (0, 0)))
        tp = tp.reshape(B, nb + 2, ATTN_BLOCK, ATTN_KV_HEADS, HEAD_DIM)
        return jnp.moveaxis(jnp.concatenate([tp[:, :-2], tp[:, 1:-1], tp[:, 2:]], axis=2), 1, 0)

    k_band, v_band = band(k_lat), band(v_lat)
    q_blocks = jnp.moveaxis(q_lat.reshape(B, nb, ATTN_BLOCK, ATTN_KV_HEADS, ATTN_GROUP, HEAD_DIM), 1, 0)
    n_loc = 3 * ATTN_BLOCK
    rel = jnp.arange(n_loc)[None, :] - ATTN_BLOCK - jnp.arange(ATTN_BLOCK)[:, None]
    in_window = jnp.abs(rel) <= WINDOW

    def attend_block(args):
        q, k, v, blk = args
        key_pos = blk * ATTN_BLOCK - ATTN_BLOCK + jnp.arange(n_loc)
        ok = in_window & ((key_pos >= 0) & (key_pos < L))[None, :]
        s_lat = jnp.einsum('bqhgd,bkhd->bhgqk', q, k).astype(jnp.float32)
        s_lat = jnp.where(ok, s_lat, NEG_INF)
        s_ctx = jnp.einsum('bqhgd,bkhd->bhgqk', q, k_ctx).astype(jnp.float32)
        p = softmax_with_sink(jnp.concatenate([s_lat, s_ctx], axis=-1), sink_g).astype(v.dtype)
        return (jnp.einsum('bhgqk,bkhd->bqhgd', p[..., :n_loc], v)
                + jnp.einsum('bhgqk,bkhd->bqhgd', p[..., n_loc:], v_ctx))

    o_lat = lax.map(attend_block, (q_blocks, k_band, v_band, jnp.arange(nb)))
    o_lat = jnp.moveaxis(o_lat, 0, 1).reshape(B, L, q_cols)
    y_lat = o_lat @ w_o
    if not need_ctx:
        return y_lat, None
    s_c = jnp.einsum('bqhgd,bkhd->bhgqk', q_ctx, k_ctx).astype(jnp.float32)
    p_c = softmax_with_sink(s_c, sink_g).astype(v_ctx.dtype)
    o_ctx = jnp.einsum('bhgqk,bkhd->bqhgd', p_c, v_ctx).reshape(B, h_ctx.shape[1], q_cols)
    return y_lat, o_ctx @ w_o


def reverse_segments(t, n_ctx):
    return jnp.concatenate([t[:, :n_ctx][:, ::-1], t[:, n_ctx:][:, ::-1]], axis=1)


def chunk_gated_scan(q, k, v, log_g):
    B, T, H, dk = q.shape
    dv = v.shape[-1]
    n = T // SCAN_CHUNK

    def chunks(t):
        return jnp.moveaxis(t.astype(jnp.float32).reshape(B, n, SCAN_CHUNK, H, t.shape[-1]), 1, 0)

    lower = jnp.tril(jnp.ones((SCAN_CHUNK, SCAN_CHUNK), dtype=bool))

    def step(S, xs):
        qc, kc, vc, gc = xs
        b = jnp.cumsum(gc, axis=1)
        q_dec = qc * jnp.exp(b)
        k_inv = kc * jnp.exp(-b)
        A = jnp.where(lower, jnp.einsum('bqhd,bkhd->bhqk', q_dec, k_inv), 0.0)
        o = jnp.einsum('bhqk,bkhv->bqhv', A, vc) + jnp.einsum('bqhd,bhdv->bqhv', q_dec, S)
        b_last = b[:, -1]
        k_end = kc * jnp.exp(b_last[:, None] - b)
        S = jnp.exp(b_last)[..., None] * S + jnp.einsum('bkhd,bkhv->bhdv', k_end, vc)
        return S, o

    S0 = jnp.zeros((B, H, dk, dv), jnp.float32)
    _, o = lax.scan(step, S0, (chunks(q), chunks(k), chunks(v), chunks(log_g)))
    return jnp.moveaxis(o, 0, 1).reshape(B, T, H, dv).astype(v.dtype)


def bidir_gated_scan(q, v, k_fwd, g_fwd, k_bwd, g_bwd, n_ctx):
    rev = lambda t: reverse_segments(t, n_ctx)
    o_f = chunk_gated_scan(q, k_fwd, v, g_fwd)
    o_b = chunk_gated_scan(rev(q), rev(k_bwd), rev(v), rev(g_bwd))
    return o_f + rev(o_b)


def gla_mixer(h_lat, h_ctx, w_in, w_gate_down, w_gate_up, gate_bias, g_norm, w_o, need_ctx):
    n_ctx = h_ctx.shape[1]
    h = jnp.concatenate([h_ctx, h_lat], axis=1)
    B, T, _ = h.shape
    z = h @ w_in
    q = z[..., :GLA_KEY_DIM].reshape(B, T, GLA_HEADS, GLA_DK) * (GLA_DK ** -0.5)
    k = z[..., GLA_KEY_DIM:2 * GLA_KEY_DIM].reshape(B, T, GLA_HEADS, GLA_DK)
    v = z[..., 2 * GLA_KEY_DIM:2 * GLA_KEY_DIM + GLA_VAL_DIM].reshape(B, T, GLA_HEADS, GLA_DV)
    out_gate = z[..., 2 * GLA_KEY_DIM + GLA_VAL_DIM:]

    def log_decay(d):
        zg = (h @ w_gate_down[d]) @ w_gate_up[d] + gate_bias[d]
        return (jax.nn.log_sigmoid(zg.astype(jnp.float32)) / GLA_TAU).reshape(B, T, GLA_HEADS, GLA_DK)

    o = bidir_gated_scan(q, v, k, log_decay(0), k, log_decay(1), n_ctx)
    o = rms_norm(o, g_norm).reshape(B, T, GLA_VAL_DIM) * jax.nn.silu(out_gate)
    y_lat = o[:, n_ctx:] @ w_o
    y_ctx = o[:, :n_ctx] @ w_o if need_ctx else None
    return y_lat, y_ctx


def centred_shift(h):
    hp = jnp.pad(h, ((0, 0), (1, 1), (0, 0)))
    return 0.5 * (hp[:, :-2] + hp[:, 2:]) - h


def rwkv7_scan(r, decay, kk, a, k, v):
    B, T, H, N = r.shape

    def step(S, xs):
        r_t, w_t, kk_t, a_t, k_t, v_t = xs
        sa = jnp.einsum('bhvk,bhk->bhv', S, -kk_t)
        S = (S * w_t[:, :, None, :] + sa[..., None] * (kk_t * a_t)[:, :, None, :]
             + v_t[..., None] * k_t[:, :, None, :])
        return S, jnp.einsum('bhvk,bhk->bhv', S, r_t)

    tm = lambda t: jnp.moveaxis(t.astype(jnp.float32), 1, 0)
    S0 = jnp.zeros((B, H, N, N), jnp.float32)
    _, y = lax.scan(step, S0, (tm(r), tm(decay), tm(kk), tm(a), tm(k), tm(v)))
    return jnp.moveaxis(y, 0, 1)


def rwkv7_mixer(h_lat, h_ctx, mix, w_rkv, w0, w_down, w_up, a0, a_down, a_up, g_down, g_up,
                k_k, k_a, r_k, ln_w, ln_b, w_o, need_ctx):
    n_ctx = h_ctx.shape[1]
    h = jnp.concatenate([h_ctx, h_lat], axis=1)
    dx = jnp.concatenate([centred_shift(h_ctx), centred_shift(h_lat)], axis=1)
    B, T, D = h.shape
    hm = h[None] + dx[None] * mix[:, None, None, :]
    r, k, v = jnp.einsum('nbtd,nde->nbte', hm[:3], w_rkv)
    hw, ha, hg = hm[3], hm[4], hm[5]
    heads = lambda t: t.reshape(B, T, RWKV_HEADS, RWKV_HEAD_SIZE)
    g = jax.nn.sigmoid(hg @ g_down) @ g_up
    kk = heads((k * k_k).astype(jnp.float32))
    kk = kk / jnp.maximum(jnp.sqrt(jnp.sum(kk * kk, axis=-1, keepdims=True)), L2_EPS)

    def direction(d):
        w_log = -jax.nn.softplus(-(w0[d] + jnp.tanh(hw @ w_down[d]) @ w_up[d]).astype(jnp.float32)) - 0.5
        a = jax.nn.sigmoid((a0[d] + (ha @ a_down[d]) @ a_up[d]).astype(jnp.float32))
        return heads(jnp.exp(-jnp.exp(w_log))), heads(a), heads(k * (1 + (a - 1) * k_a))

    dec_f, a_f, k_f = direction(0)
    dec_b, a_b, k_b = direction(1)
    r_h, v_h = heads(r), heads(v)
    rev = lambda t: reverse_segments(t, n_ctx)
    y = (rwkv7_scan(r_h, dec_f, kk, a_f, k_f, v_h)
         + rev(rwkv7_scan(rev(r_h), rev(dec_b), rev(kk), rev(a_b), rev(k_b), rev(v_h))))
    mu = jnp.mean(y, axis=-1, keepdims=True)
    var = jnp.mean(jnp.square(y - mu), axis=-1, keepdims=True)
    yn = ((y - mu) * lax.rsqrt(var + RWKV_LN_EPS) * ln_w.reshape(RWKV_HEADS, RWKV_HEAD_SIZE)
          + ln_b.reshape(RWKV_HEADS, RWKV_HEAD_SIZE))
    bonus = jnp.sum(r_h * (0.5 * (k_f + k_b)) * r_k, axis=-1, keepdims=True) * v_h
    out = (yn + bonus).reshape(B, T, D).astype(h.dtype) * g
    y_lat = out[:, n_ctx:] @ w_o
    y_ctx = out[:, :n_ctx] @ w_o if need_ctx else None
    return y_lat, y_ctx


def hgrn_lower_bound(lb_param, layer):
    p = jax.nn.softmax(lb_param.astype(jnp.float32), axis=0)
    return (jnp.cumsum(p, axis=0) - p[0])[layer]


def hgrn2_mixer(h_lat, h_ctx, w_in, w_f, lower_bound, g_norm, w_o, need_ctx):
    n_ctx = h_ctx.shape[1]
    h = jnp.concatenate([h_ctx, h_lat], axis=1)
    B, T, _ = h.shape
    z = h @ w_in
    q = jax.nn.silu(z[..., :HGRN_FORGET_DIM]).reshape(B, T, HGRN_HEADS, HGRN_EXPAND)
    i_in = z[..., HGRN_FORGET_DIM:HGRN_FORGET_DIM + D_MODEL].reshape(B, T, HGRN_HEADS, HGRN_IN_DIM)
    out_gate = z[..., HGRN_FORGET_DIM + D_MODEL:]

    def gates(d):
        f = lower_bound + (1 - lower_bound) * jax.nn.sigmoid((h @ w_f[d]).astype(jnp.float32))
        f = f.reshape(B, T, HGRN_HEADS, HGRN_EXPAND)
        return 1 - f, jnp.log(f)

    k_fwd, g_fwd = gates(0)
    k_bwd, g_bwd = gates(1)
    o = bidir_gated_scan(q, i_in, k_fwd, g_fwd, k_bwd, g_bwd, n_ctx)
    o = rms_norm(o, g_norm).reshape(B, T, D_MODEL) * jax.nn.silu(out_gate)
    y_lat = o[:, n_ctx:] @ w_o
    y_ctx = o[:, :n_ctx] @ w_o if need_ctx else None
    return y_lat, y_ctx


def setup_inputs(seed: int = 0) -> dict:
    key = jax.random.key(seed)
    keys = iter(jax.random.split(key, 48))
    D = D_MODEL

    def normal(shape, scale):
        return jax.random.normal(next(keys), shape, jnp.float32) * scale

    def gain(shape):
        return 1.0 + normal(shape, 0.02)

    nA, nB, nC, nH = N_ATTN_LAYERS, N_GLA_LAYERS, N_RWKV_LAYERS, N_HGRN_LAYERS
    return {
        "x": normal((BATCH, SEQ, D), 1.0),
        "c": normal((BATCH, D), 1.0),
        "ctx": normal((BATCH, CTX_LEN, D), 1.0),
        "c_ctx": normal((D,), 1.0),
        "w_mod": normal((DEPTH, D, N_MOD * D), 0.5 * D ** -0.5),
        "b_mod": normal((DEPTH, N_MOD * D), 0.01),
        "g_pre_mix": gain((DEPTH, D)),
        "g_post_mix": gain((DEPTH, D)),
        "g_pre_mlp": gain((DEPTH, D)),
        "g_post_mlp": gain((DEPTH, D)),
        "w_mlp_in": normal((DEPTH, D, MLP_HIDDEN), D ** -0.5),
        "w_mlp_out": normal((DEPTH, MLP_HIDDEN, D), MLP_HIDDEN ** -0.5),
        "attn_w_qkv": normal((nA, D, (ATTN_HEADS + 2 * ATTN_KV_HEADS) * HEAD_DIM), D ** -0.5),
        "attn_w_o": normal((nA, ATTN_HEADS * HEAD_DIM, D), (ATTN_HEADS * HEAD_DIM) ** -0.5),
        "attn_sink": normal((nA, ATTN_HEADS), 0.5),
        "gla_w_in": normal((nB, D, 2 * GLA_KEY_DIM + 2 * GLA_VAL_DIM), D ** -0.5),
        "gla_w_gate_down": normal((nB, 2, D, GLA_GATE_RANK), D ** -0.5),
        "gla_w_gate_up": normal((nB, 2, GLA_GATE_RANK, GLA_KEY_DIM), GLA_GATE_RANK ** -0.5),
        "gla_gate_bias": normal((nB, 2, GLA_KEY_DIM), 0.1),
        "gla_g_norm": gain((nB, GLA_DV)),
        "gla_w_o": normal((nB, GLA_VAL_DIM, D), GLA_VAL_DIM ** -0.5),
        "rwkv_mix": jax.random.uniform(next(keys), (nC, 6, D), jnp.float32),
        "rwkv_w_rkv": normal((nC, 3, D, D), D ** -0.5),
        "rwkv_w0": -1.5 + normal((nC, 2, D), 0.5),
        "rwkv_w_down": normal((nC, 2, D, RWKV_DECAY_RANK), D ** -0.5),
        "rwkv_w_up": normal((nC, 2, RWKV_DECAY_RANK, D), 0.1 * RWKV_DECAY_RANK ** -0.5),
        "rwkv_a0": normal((nC, 2, D), 0.1),
        "rwkv_a_down": normal((nC, 2, D, RWKV_AAA_RANK), D ** -0.5),
        "rwkv_a_up": normal((nC, 2, RWKV_AAA_RANK, D), RWKV_AAA_RANK ** -0.5),
        "rwkv_g_down": normal((nC, D, RWKV_GATE_RANK), D ** -0.5),
        "rwkv_g_up": normal((nC, RWKV_GATE_RANK, D), RWKV_GATE_RANK ** -0.5),
        "rwkv_k_k": 0.85 + normal((nC, D), 0.02),
        "rwkv_k_a": gain((nC, D)),
        "rwkv_r_k": normal((nC, RWKV_HEADS, RWKV_HEAD_SIZE), 0.1),
        "rwkv_ln_w": gain((nC, D)),
        "rwkv_ln_b": normal((nC, D), 0.02),
        "rwkv_w_o": normal((nC, D, D), D ** -0.5),
        "hgrn_w_in": normal((nH, D, HGRN_FORGET_DIM + 2 * D), D ** -0.5),
        "hgrn_w_f": normal((nH, 2, D, HGRN_FORGET_DIM), D ** -0.5),
        "hgrn_lb": normal((DEPTH, HGRN_FORGET_DIM), 0.1),
        "hgrn_g_norm": gain((nH, HGRN_IN_DIM)),
        "hgrn_w_o": normal((nH, D, D), D ** -0.5),
    }


def reference(x, c, ctx, c_ctx, w_mod, b_mod, g_pre_mix, g_post_mix, g_pre_mlp, g_post_mlp,
              w_mlp_in, w_mlp_out, attn_w_qkv, attn_w_o, attn_sink,
              gla_w_in, gla_w_gate_down, gla_w_gate_up, gla_gate_bias, gla_g_norm, gla_w_o,
              rwkv_mix, rwkv_w_rkv, rwkv_w0, rwkv_w_down, rwkv_w_up, rwkv_a0, rwkv_a_down,
              rwkv_a_up, rwkv_g_down, rwkv_g_up, rwkv_k_k, rwkv_k_a, rwkv_r_k, rwkv_ln_w,
              rwkv_ln_b, rwkv_w_o, hgrn_w_in, hgrn_w_f, hgrn_lb, hgrn_g_norm, hgrn_w_o):
    n_latent = x.shape[1]
    rows = n_latent // GRID_W
    cos, sin = axial_rope_tables(rows)
    c_lat = jax.nn.silu(c)
    c_con = jax.nn.silu(c_ctx)
    x_lat, x_ctx = x, ctx
    for i in range(DEPTH):
        kind, j = i % N_MIXERS, i // N_MIXERS
        need_ctx = i < DEPTH - 1
        m_lat = jnp.split((c_lat @ w_mod[i] + b_mod[i])[:, None, :], N_MOD, axis=-1)
        m_ctx = jnp.split(c_con @ w_mod[i] + b_mod[i], N_MOD, axis=-1)
        h_lat = modulate(x_lat, g_pre_mix[i], m_lat[0], m_lat[1])
        h_ctx = modulate(x_ctx, g_pre_mix[i], m_ctx[0], m_ctx[1])
        if kind == 0:
            y_lat, y_ctx = windowed_gqa_sink(h_lat, h_ctx, attn_w_qkv[j], attn_w_o[j], attn_sink[j],
                                             cos, sin, need_ctx)
        elif kind == 1:
            y_lat, y_ctx = gla_mixer(h_lat, h_ctx, gla_w_in[j], gla_w_gate_down[j], gla_w_gate_up[j],
                                     gla_gate_bias[j], gla_g_norm[j], gla_w_o[j], need_ctx)
        elif kind == 2:
            y_lat, y_ctx = rwkv7_mixer(h_lat, h_ctx, rwkv_mix[j], rwkv_w_rkv[j], rwkv_w0[j],
                                       rwkv_w_down[j], rwkv_w_up[j], rwkv_a0[j], rwkv_a_down[j],
                                       rwkv_a_up[j], rwkv_g_down[j], rwkv_g_up[j], rwkv_k_k[j],
                                       rwkv_k_a[j], rwkv_r_k[j], rwkv_ln_w[j], rwkv_ln_b[j],
                                       rwkv_w_o[j], need_ctx)
        else:
            y_lat, y_ctx = hgrn2_mixer(h_lat, h_ctx, hgrn_w_in[j], hgrn_w_f[j],
                                       hgrn_lower_bound(hgrn_lb, i), hgrn_g_norm[j], hgrn_w_o[j],
                                       need_ctx)
        x_lat = x_lat + m_lat[2] * rms_norm(y_lat, g_post_mix[i])
        f_lat = channel_mlp(modulate(x_lat, g_pre_mlp[i], m_lat[3], m_lat[4]), w_mlp_in[i], w_mlp_out[i])
        x_lat = x_lat + m_lat[5] * rms_norm(f_lat, g_post_mlp[i])
        if need_ctx:
            x_ctx = x_ctx + m_ctx[2] * rms_norm(y_ctx, g_post_mix[i])
            f_ctx = channel_mlp(modulate(x_ctx, g_pre_mlp[i], m_ctx[3], m_ctx[4]), w_mlp_in[i], w_mlp_out[i])
            x_ctx = x_ctx + m_ctx[5] * rms_norm(f_ctx, g_post_mlp[i])
    return x_lat
```

```cpp
#include <hip/hip_runtime.h>
#include <hip/hip_cooperative_groups.h>
#include <cstdio>
#include <cstdint>
namespace cg = cooperative_groups;
namespace pg8 {
#define PG8_LAS __attribute__((address_space(3)))
typedef unsigned short bf16_t;
typedef short bf16x8 __attribute__((ext_vector_type(8)));
typedef float f32x4 __attribute__((ext_vector_type(4)));
typedef unsigned u32x4 __attribute__((ext_vector_type(4)));
constexpr int BM = 256, BK = 64, HALF = 128, HTB = HALF * BK * 2  , STAGE_BYTES = 8 * HTB, NXCD = 8, WGM = 8;

__host__ __device__ __forceinline__ int lds_byte(int r, int c) { const int st = (r >> 4) * 2 + (c >> 5), rr = r & 15, cc = c & 31, ob = rr * 64 + cc * 2; return st * 1024 + (ob ^ (((ob >> 9) & 1) << 5)); }
__host__ __device__ __forceinline__ void stage_rc(int b, int& R, int& C) { const int st = b / 1024, sb = b % 1024, swz = sb ^ (((sb >> 9) & 1) << 5); R = (st >> 1) * 16 + swz / 64; C = (st & 1) * 32 + (swz % 64) / 2; }
__host__ __device__ __forceinline__ int perm32(int rho) { const int n = rho >> 4, i = rho & 15; return 8 * (i >> 2) + 4 * n + (i & 3); }

struct Unit { int pm, pn; };
struct Gemm { const bf16_t* A; const bf16_t* Bt; int M, N, K; };

struct StaticOrder {
    int nM, nN, nwg, G, c;
    __host__ __device__ void init(int M, int N, int G_, int c_) { nM = M / BM; nN = N / BM; nwg = nM * nN; G = G_; c = c_; }
    __host__ __device__ bool next(int i, Unit& u) const {
        const long L = (long)i * G + c; if (L >= nwg) return false;
        int wgid = (int)L; { const int q = nwg / NXCD, r = nwg % NXCD, xcd = wgid % NXCD, off = wgid / NXCD; wgid = (xcd < r ? xcd * (q + 1) : r * (q + 1) + (xcd - r) * q) + off; }
        const int nig = WGM * nN, gid = wgid / nig, fm = gid * WGM, gsz = (nM - fm) < WGM ? (nM - fm) : WGM;
        u.pm = fm + ((wgid % nig) % gsz); u.pn = (wgid % nig) / gsz; return true;
    }
    __device__ __forceinline__ void a_ready(const Unit&) const {}
    __device__ __forceinline__ void done(const Unit&) const {}
};

__device__ __forceinline__ unsigned cvt_pk_bf16(float lo, float hi) { unsigned r; asm volatile("v_cvt_pk_bf16_f32 %0, %1, %2" : "=v"(r) : "v"(lo), "v"(hi)); return r; }
typedef float f32x2 __attribute__((ext_vector_type(2)));
template <class Epi, class Sched, bool ALIGN_EPI = false, bool SP2 = false>
__device__ __forceinline__ void gemm_phase(PG8_LAS unsigned char* lds, const Gemm g, const Sched& S, const Epi& E, const int tid) {
    const int wid = __builtin_amdgcn_readfirstlane(tid >> 6), lane = tid & 63, wr = wid >> 2, wc = wid & 3, fr = lane & 15, fq = lane >> 4;
    const int K = g.K, nt = K / BK;
    unsigned voffA[2], voffB[2];
#pragma unroll
    for (int i = 0; i < 2; ++i) { int R, C; stage_rc(tid * 16 + i * 8192, R, C); const int Rb = Epi::PERM ? ((R & ~31) + perm32(R & 31)) : R;
        voffA[i] = (unsigned)(R * K + C) * 2u; voffB[i] = (unsigned)(Rb * K + C) * 2u; }
    const size_t kstep = (size_t)(BK * 2);
    const size_t hstep = (size_t)HALF * K * 2;
    const size_t tstep = 2 * hstep;
    const unsigned ldsw = (unsigned)wid * 1024u;
    const int aoff = lds_byte(wr * 64 + fr, fq * 8), boff = lds_byte(wc * 32 + fr, fq * 8);
#define PG8_SA(b, h) (((b) * 2 + (h)) * HTB)
#define PG8_SB(b, h) ((4 + (b) * 2 + (h)) * HTB)
#define PG8_STAGE(bufoff, gbase, voff) do { _Pragma("unroll") for (int _i = 0; _i < 2; ++_i) \
        __builtin_amdgcn_global_load_lds((const unsigned*)((const char*)(gbase) + (voff)[_i]), (PG8_LAS unsigned*)(lds + (bufoff) + ldsw + _i * 8192), 16, 0, 0); } while (0)
#define PG8_LDA(dst, b, h) do { _Pragma("unroll") for (int m = 0; m < 4; ++m) _Pragma("unroll") for (int k = 0; k < 2; ++k) dst[m][k] = *(const PG8_LAS bf16x8*)(lds + PG8_SA(b, h) + aoff + m * 2048 + k * 1024); } while (0)
#define PG8_LDB(dst, b, h) do { _Pragma("unroll") for (int n = 0; n < 2; ++n) _Pragma("unroll") for (int k = 0; k < 2; ++k) dst[n][k] = *(const PG8_LAS bf16x8*)(lds + PG8_SB(b, h) + boff + n * 2048 + k * 1024); } while (0)
#define PG8_MMA(ai, bj, At, Bt) do { __builtin_amdgcn_s_setprio(1); _Pragma("unroll") for (int m = 0; m < 4; ++m) _Pragma("unroll") for (int n = 0; n < 2; ++n) _Pragma("unroll") for (int k = 0; k < 2; ++k) \
        acc[ai][bj][m][n] = __builtin_amdgcn_mfma_f32_16x16x32_bf16(Bt[n][k], At[m][k], acc[ai][bj][m][n], 0, 0, 0); __builtin_amdgcn_s_setprio(0); } while (0)
#define PG8_WAIT_V(n) asm volatile("s_waitcnt vmcnt(" #n ")" ::: "memory")
#define PG8_WAIT_L(n) asm volatile("s_waitcnt lgkmcnt(" #n ")" ::: "memory")
#define PG8_BAR __builtin_amdgcn_s_barrier()
#define PG8_SCHED __builtin_amdgcn_sched_barrier(0)
    Unit cur, nxt; int ui = 0;
    if (!S.next(0, cur)) return;
    f32x4 acc[2][2][4][2];
#pragma unroll
    for (int a = 0; a < 2; ++a)
#pragma unroll
        for (int b = 0; b < 2; ++b)
#pragma unroll
            for (int m = 0; m < 4; ++m)
#pragma unroll
                for (int n = 0; n < 2; ++n) acc[a][b][m][n] = (f32x4){0.f, 0.f, 0.f, 0.f};
    bf16x8 At[4][2], B0[2][2], B1[2][2];
    const char* cA = (const char*)g.A + (size_t)cur.pm * tstep; const char* cB = (const char*)g.Bt + (size_t)cur.pn * tstep;
    S.a_ready(cur);
    if constexpr (SP2) {
        PG8_STAGE(PG8_SB(0, 0), cB, voffB); PG8_STAGE(PG8_SB(0, 1), cB + hstep, voffB); PG8_STAGE(PG8_SA(0, 0), cA, voffA); PG8_STAGE(PG8_SA(0, 1), cA + hstep, voffA);
        if (wr == 1) PG8_BAR;
        PG8_WAIT_V(2); PG8_BAR;
        PG8_STAGE(PG8_SB(1, 0), cB + kstep, voffB); PG8_STAGE(PG8_SA(1, 0), cA + kstep, voffA); PG8_STAGE(PG8_SB(1, 1), cB + hstep + kstep, voffB);
        PG8_WAIT_V(6); PG8_BAR;
    } else {
        PG8_STAGE(PG8_SB(0, 0), cB, voffB); PG8_STAGE(PG8_SA(0, 0), cA, voffA); PG8_STAGE(PG8_SB(0, 1), cB + hstep, voffB); PG8_STAGE(PG8_SA(0, 1), cA + hstep, voffA);
        if (wr == 1) PG8_BAR;
        PG8_WAIT_V(4); PG8_BAR;
        PG8_STAGE(PG8_SB(1, 0), cB + kstep, voffB); PG8_STAGE(PG8_SA(1, 0), cA + kstep, voffA); PG8_STAGE(PG8_SB(1, 1), cB + hstep + kstep, voffB);
        PG8_WAIT_V(6); PG8_BAR;
    }
    for (;;) {
        const bool has_next = S.next(ui + 1, nxt);
        const char* nA = has_next ? (const char*)g.A + (size_t)nxt.pm * tstep : cA; const char* nB = has_next ? (const char*)g.Bt + (size_t)nxt.pn * tstep : cB;
        for (int t = 0; t < nt; t += 2) {
            const bool last = (t == nt - 2);
            const char* a1 = cA + (size_t)(t + 1) * kstep;
            const char* a2 = last ? nA : cA + (size_t)(t + 2) * kstep; const char* b2 = last ? nB : cB + (size_t)(t + 2) * kstep;
            const char* a3 = a2 + kstep; const char* b3 = b2 + kstep;
            if (last && has_next) S.a_ready(nxt);
            if constexpr (SP2) {
            PG8_LDB(B0, 0, 0); PG8_LDB(B1, 0, 1); PG8_SCHED; PG8_LDA(At, 0, 0); PG8_STAGE(PG8_SA(1, 1), a1 + hstep, voffA);
            PG8_WAIT_V(8); PG8_WAIT_L(0); PG8_BAR; PG8_MMA(0, 0, At, B0); PG8_MMA(0, 1, At, B1); PG8_BAR; PG8_SCHED;
            PG8_LDA(At, 0, 1); PG8_STAGE(PG8_SB(0, 0), b2, voffB); PG8_STAGE(PG8_SB(0, 1), b2 + hstep, voffB); PG8_STAGE(PG8_SA(0, 0), a2, voffA);
            PG8_WAIT_V(8); PG8_WAIT_L(0); PG8_BAR; PG8_MMA(1, 0, At, B0); PG8_MMA(1, 1, At, B1); PG8_BAR; PG8_SCHED;
            PG8_LDB(B0, 1, 0); PG8_LDB(B1, 1, 1); PG8_SCHED; PG8_LDA(At, 1, 0); PG8_STAGE(PG8_SA(0, 1), a2 + hstep, voffA);
            PG8_WAIT_V(8); PG8_WAIT_L(0); PG8_BAR; PG8_MMA(0, 0, At, B0); PG8_MMA(0, 1, At, B1); PG8_BAR; PG8_SCHED;
            PG8_LDA(At, 1, 1); PG8_STAGE(PG8_SB(1, 0), b3, voffB); PG8_STAGE(PG8_SB(1, 1), b3 + hstep, voffB); PG8_STAGE(PG8_SA(1, 0), a3, voffA);
            PG8_WAIT_V(8); PG8_WAIT_L(0); PG8_BAR; PG8_MMA(1, 0, At, B0); PG8_MMA(1, 1, At, B1); PG8_BAR; PG8_SCHED;
            } else {
            PG8_LDB(B0, 0, 0); PG8_SCHED; PG8_LDA(At, 0, 0); PG8_STAGE(PG8_SA(1, 1), a1 + hstep, voffA);
            PG8_WAIT_L(8); PG8_BAR; PG8_WAIT_L(0); PG8_MMA(0, 0, At, B0); PG8_BAR; PG8_SCHED;
            PG8_LDB(B1, 0, 1); PG8_STAGE(PG8_SB(0, 0), b2, voffB);
            PG8_BAR; PG8_WAIT_L(0); PG8_MMA(0, 1, At, B1); PG8_BAR;
            PG8_LDA(At, 0, 1); PG8_STAGE(PG8_SA(0, 0), a2, voffA);
            PG8_BAR; PG8_WAIT_L(0); PG8_MMA(1, 0, At, B0); PG8_BAR; PG8_SCHED;
            PG8_STAGE(PG8_SB(0, 1), b2 + hstep, voffB);
            PG8_WAIT_V(6); PG8_BAR; PG8_MMA(1, 1, At, B1); PG8_BAR;
            PG8_LDB(B0, 1, 0); PG8_SCHED; PG8_LDA(At, 1, 0); PG8_STAGE(PG8_SA(0, 1), a2 + hstep, voffA);
            PG8_WAIT_L(8); PG8_BAR; PG8_WAIT_L(0); PG8_MMA(0, 0, At, B0); PG8_BAR; PG8_SCHED;
            PG8_LDB(B1, 1, 1); PG8_STAGE(PG8_SB(1, 0), b3, voffB);
            PG8_BAR; PG8_WAIT_L(0); PG8_MMA(0, 1, At, B1); PG8_BAR;
            PG8_LDA(At, 1, 1); PG8_STAGE(PG8_SA(1, 0), a3, voffA);
            PG8_BAR; PG8_WAIT_L(0); PG8_MMA(1, 0, At, B0); PG8_BAR; PG8_SCHED;
            PG8_STAGE(PG8_SB(1, 1), b3 + hstep, voffB);
            PG8_WAIT_V(6); PG8_BAR; PG8_MMA(1, 1, At, B1); PG8_BAR;
            }
        }
        if constexpr (ALIGN_EPI) { if (wr == 0) PG8_BAR; }
        if constexpr (!Epi::AFTER_DRAIN) { E(acc, cur, wr, wc, fr, fq); S.done(cur); }
        if (!has_next) break;
#pragma unroll
        for (int a = 0; a < 2; ++a)
#pragma unroll
            for (int b = 0; b < 2; ++b)
#pragma unroll
                for (int m = 0; m < 4; ++m)
#pragma unroll
                    for (int n = 0; n < 2; ++n) acc[a][b][m][n] = (f32x4){0.f, 0.f, 0.f, 0.f};
        cur = nxt; cA = nA; cB = nB; ++ui;
        if constexpr (ALIGN_EPI) { if (wr == 1) PG8_BAR; }
    }
    PG8_WAIT_V(0);
    if constexpr (!ALIGN_EPI) { if (wr == 0) PG8_BAR; }
    PG8_BAR;
    if constexpr (Epi::AFTER_DRAIN) { E.fused(acc, cur, wr, wc, fr, fq, lds, wid, lane); S.done(cur); }
#undef PG8_SA
#undef PG8_SB
#undef PG8_STAGE
#undef PG8_LDA
#undef PG8_LDB
#undef PG8_MMA
#undef PG8_WAIT_V
#undef PG8_WAIT_L
#undef PG8_BAR
#undef PG8_SCHED
}
}

#define DI __device__ __forceinline__
#define LAS __attribute__((address_space(3)))
typedef unsigned short bf16_t;
typedef short bf16x8 __attribute__((ext_vector_type(8)));
typedef float f32x4 __attribute__((ext_vector_type(4)));
typedef float f32x2 __attribute__((ext_vector_type(2)));
typedef unsigned u32x4 __attribute__((ext_vector_type(4)));
typedef unsigned u32x2 __attribute__((ext_vector_type(2)));

constexpr int DM = 1024, NBATCH = 32, NLAT = 2048, NCTX = 256, TT = 2304, MTOK = NBATCH * TT, HID = 4096;
constexpr int NPH = 35;
constexpr int LDS_BYTES = 147456;
constexpr size_t MiB = 1u << 20;
constexpr size_t WS_W = 0;
constexpr size_t WS_MOD = 108 * MiB;
constexpr size_t WS_SMALL = 112 * MiB;
constexpr size_t WS_XC = 113 * MiB;
constexpr size_t WS_HA = 145 * MiB;
constexpr size_t WS_Y = 289 * MiB;
constexpr size_t WS_BIG = 433 * MiB;
constexpr size_t WS_T = 1009 * MiB;
constexpr size_t WS_CTL = 1018 * MiB;
constexpr size_t WS_END = 1019 * MiB;
constexpr size_t W_MLP_IN = 0, W_MLP_OUT = 4 * 4194304ull;
constexpr size_t W_A_QKV = 8 * 4194304ull, W_A_WO = W_A_QKV + 1572864;
constexpr size_t W_G_WIN = W_A_WO + 1048576, W_G_WOG = W_G_WIN + 2359296, W_G_WO = W_G_WOG + 1048576;
constexpr size_t W_R_B2 = W_G_WO + 1048576, W_R_GUP = W_R_B2 + 7340032, W_R_WO = W_R_GUP + 262144;
constexpr size_t W_H_WIN = W_R_WO + 1048576, W_H_WOG = W_H_WIN + 4194304, W_H_WO = W_H_WOG + 1048576;
constexpr size_t W_TOTAL = W_H_WO + 1048576;
static_assert(W_TOTAL * 2 <= WS_MOD, "weights fit");
constexpr size_t BIG_VT = 216 * MiB;
constexpr size_t BIG_LR = 432 * MiB, BIG_SG = 468 * MiB, BIG_BS = 504 * MiB;

struct P {
    const float* in[42];
    float* out;
    unsigned char* ws;
    int ph_lo, ph_hi;
};

typedef __bf16 bf16x2_t __attribute__((ext_vector_type(2)));
DI unsigned cvtpk(float lo, float hi) { const f32x2 v = (f32x2){lo, hi}; const bf16x2_t b = __builtin_convertvector(v, bf16x2_t); return __builtin_bit_cast(unsigned, b); }
DI unsigned short f2bf(float f) { return (unsigned short)(cvtpk(f, f) & 0xffffu); }
DI float bf2f(unsigned short u) { return __uint_as_float((unsigned)u << 16); }
DI unsigned pk2(float lo, float hi) { return (unsigned)f2bf(lo) | ((unsigned)f2bf(hi) << 16); }
DI float sigmoid_f(float x) { return __builtin_amdgcn_rcpf(1.f + __expf(-x)); }
DI float silu_f(float x) { return x * __builtin_amdgcn_rcpf(1.f + __expf(-x)); }
DI float wave_sum(float v) {
#pragma unroll
    for (int o = 1; o < 64; o <<= 1) v += __shfl_xor(v, o);
    return v;
}
#define DPPF(v, ctrl) __int_as_float(__builtin_amdgcn_mov_dpp(__float_as_int(v), (ctrl), 0xF, 0xF, true))
DI float red16(float v) { v += DPPF(v, 0xB1); v += DPPF(v, 0x4E); v += DPPF(v, 0x141); v += DPPF(v, 0x140); return v; }
DI float max16(float v) { v = fmaxf(v, __shfl_xor(v, 1)); v = fmaxf(v, __shfl_xor(v, 2)); v = fmaxf(v, __shfl_xor(v, 4)); v = fmaxf(v, __shfl_xor(v, 8)); return v; }
DI f32x4 bf4_to_f4(u32x2 w) { return (f32x4){__uint_as_float(w.x << 16), __uint_as_float(w.x & 0xffff0000u), __uint_as_float(w.y << 16), __uint_as_float(w.y & 0xffff0000u)}; }
DI u32x2 f4_to_bf4(f32x4 v) { return (u32x2){pk2(v.x, v.y), pk2(v.z, v.w)}; }
#define LDS_WAIT() asm volatile("s_waitcnt lgkmcnt(0)" ::: "memory")
DI int tok_of(int dir, int s) { return dir == 0 ? s : (s < NCTX ? (NCTX - 1 - s) : (TT + NCTX - 1 - s)); }

struct PZ {
    const P& k; int z;
    DI const float* in(int i) const { return k.in[i + z]; }
    DI unsigned char* ws() const { return k.ws + z; }
    DI float* out() const { return k.out + z; }
};
DI void tr_job(const float* W, int ldsrc, int col0, int K, int ncols, bf16_t* WT, int ld_dst, int row_off, int col_off, const float* scale,
               LAS float* scr, int gw, int NGW, int lane) {
    const int nblk = ncols / 32, nitems = (K / 64) * nblk;
    for (int item = gw; item < nitems; item += NGW) {
        const int kb = item / nblk, nb = item % nblk, k0 = 64 * kb, n0 = 32 * nb;
#pragma unroll 8
        for (int i = 0; i < 32; ++i) {
            const int kk = 2 * i + (lane >> 5);
            float v = W[(size_t)(k0 + kk) * ldsrc + col0 + n0 + (lane & 31)];
            if (scale) v *= scale[k0 + kk];
            scr[kk * 33 + (lane & 31)] = v;
        }
        LDS_WAIT();
        const int c = lane & 7;
#pragma unroll
        for (int j = 0; j < 4; ++j) {
            const int n = (lane >> 3) + 8 * j; const LAS float* s = scr + (8 * c) * 33 + n;
            u32x4 o; o.x = pk2(s[0 * 33], s[1 * 33]); o.y = pk2(s[2 * 33], s[3 * 33]); o.z = pk2(s[4 * 33], s[5 * 33]); o.w = pk2(s[6 * 33], s[7 * 33]);
            *(u32x4*)(WT + (size_t)(row_off + n0 + n) * ld_dst + col_off + k0 + 8 * c) = o;
        }
        LDS_WAIT();
    }
}
DI void zero_rows(bf16_t* p, size_t nel, int gt, int NGT) {
    for (size_t i = (size_t)gt * 8; i < nel; i += (size_t)NGT * 8) *(u32x4*)(p + i) = (u32x4){0u, 0u, 0u, 0u};
}

DI void prep_weights(const PZ& p, LAS unsigned char* lds, int wave, int lane, int layer, int gw, int NGW, int gt, int NGT) {
    bf16_t* Wb = (bf16_t*)(p.ws() + WS_W);
    LAS float* scr = (LAS float*)(lds + wave * 16384);
    tr_job(p.in(10) + (size_t)layer * 1024 * 4096, 4096, 0, 1024, 4096, Wb + W_MLP_IN + (size_t)layer * 4194304, 1024, 0, 0, nullptr, scr, gw, NGW, lane);
    tr_job(p.in(11) + (size_t)layer * 4096 * 1024, 1024, 0, 4096, 1024, Wb + W_MLP_OUT + (size_t)layer * 4194304, 4096, 0, 0, nullptr, scr, gw, NGW, lane);
    if (layer == 0) {
        tr_job(p.in(12), 1536, 0, 1024, 1536, Wb + W_A_QKV, 1024, 0, 0, nullptr, scr, gw, NGW, lane);
        tr_job(p.in(13), 1024, 0, 1024, 1024, Wb + W_A_WO, 1024, 0, 0, nullptr, scr, gw, NGW, lane);
    } else if (layer == 1) {
        tr_job(p.in(15), 3072, 0, 1024, 2048, Wb + W_G_WIN, 1024, 0, 0, nullptr, scr, gw, NGW, lane);
        tr_job(p.in(15), 3072, 2048, 1024, 1024, Wb + W_G_WOG, 1024, 0, 0, nullptr, scr, gw, NGW, lane);
        tr_job(p.in(20), 1024, 0, 1024, 1024, Wb + W_G_WO, 1024, 0, 0, nullptr, scr, gw, NGW, lane);
        for (int i = gt; i < 32 * 1024; i += NGT) { const int n = i >> 10, k = i & 1023; Wb[W_G_WIN + (size_t)(2048 + n) * 1024 + k] = f2bf(p.in(16)[((size_t)(n >> 4) * 1024 + k) * 16 + (n & 15)]); }
        zero_rows(Wb + W_G_WIN + (size_t)2080 * 1024, (size_t)224 * 1024, gt, NGT);
    } else if (layer == 2) {
        for (int j = 0; j < 3; ++j) {
            tr_job(p.in(22) + (size_t)j * 1048576, 1024, 0, 1024, 1024, Wb + W_R_B2, 2048, j * 1024, 0, nullptr, scr, gw, NGW, lane);
            tr_job(p.in(22) + (size_t)j * 1048576, 1024, 0, 1024, 1024, Wb + W_R_B2, 2048, j * 1024, 1024, p.in(21) + j * 1024, scr, gw, NGW, lane);
        }
        for (int d = 0; d < 2; ++d) {
            tr_job(p.in(24) + (size_t)d * 65536, 64, 0, 1024, 64, Wb + W_R_B2, 2048, 3072 + d * 64, 0, nullptr, scr, gw, NGW, lane);
            tr_job(p.in(24) + (size_t)d * 65536, 64, 0, 1024, 64, Wb + W_R_B2, 2048, 3072 + d * 64, 1024, p.in(21) + 3 * 1024, scr, gw, NGW, lane);
            tr_job(p.in(27) + (size_t)d * 65536, 64, 0, 1024, 64, Wb + W_R_B2, 2048, 3200 + d * 64, 0, nullptr, scr, gw, NGW, lane);
            tr_job(p.in(27) + (size_t)d * 65536, 64, 0, 1024, 64, Wb + W_R_B2, 2048, 3200 + d * 64, 1024, p.in(21) + 4 * 1024, scr, gw, NGW, lane);
        }
        tr_job(p.in(29), 128, 0, 1024, 128, Wb + W_R_B2, 2048, 3328, 0, nullptr, scr, gw, NGW, lane);
        tr_job(p.in(29), 128, 0, 1024, 128, Wb + W_R_B2, 2048, 3328, 1024, p.in(21) + 5 * 1024, scr, gw, NGW, lane);
        zero_rows(Wb + W_R_B2 + (size_t)3456 * 2048, (size_t)128 * 2048, gt, NGT);
        tr_job(p.in(30), 1024, 0, 128, 1024, Wb + W_R_GUP, 256, 0, 0, nullptr, scr, gw, NGW, lane);
        for (int i = gt; i < 1024 * 16; i += NGT) { const int n = i >> 4, c = i & 15; *(u32x4*)(Wb + W_R_GUP + (size_t)n * 256 + 128 + c * 8) = (u32x4){0u, 0u, 0u, 0u}; }
        tr_job(p.in(36), 1024, 0, 1024, 1024, Wb + W_R_WO, 1024, 0, 0, nullptr, scr, gw, NGW, lane);
        for (int d = 0; d < 2; ++d) {
            tr_job(p.in(25) + (size_t)d * 65536, 1024, 0, 64, 1024, (bf16_t*)(p.ws() + WS_SMALL + 65536) + (size_t)d * 65536, 64, 0, 0, nullptr, scr, gw, NGW, lane);
            tr_job(p.in(28) + (size_t)d * 65536, 1024, 0, 64, 1024, (bf16_t*)(p.ws() + WS_SMALL + 65536) + (size_t)(2 + d) * 65536, 64, 0, 0, nullptr, scr, gw, NGW, lane);
        }
    } else {
        tr_job(p.in(37), 3072, 0, 1024, 1024, Wb + W_H_WIN, 1024, 0, 0, nullptr, scr, gw, NGW, lane);
        tr_job(p.in(38), 1024, 0, 1024, 1024, Wb + W_H_WIN, 1024, 1024, 0, nullptr, scr, gw, NGW, lane);
        tr_job(p.in(38) + 1048576, 1024, 0, 1024, 1024, Wb + W_H_WIN, 1024, 2048, 0, nullptr, scr, gw, NGW, lane);
        tr_job(p.in(37), 3072, 1024, 1024, 1024, Wb + W_H_WIN, 1024, 3072, 0, nullptr, scr, gw, NGW, lane);
        tr_job(p.in(37), 3072, 2048, 1024, 1024, Wb + W_H_WOG, 1024, 0, 0, nullptr, scr, gw, NGW, lane);
        tr_job(p.in(41), 1024, 0, 1024, 1024, Wb + W_H_WO, 1024, 0, 0, nullptr, scr, gw, NGW, lane);
    }
}
DI void prep_filler(const PZ& p, LAS unsigned char* lds, int tid, int wave, int lane, int layer) {
    int nb = gridDim.x; asm volatile("" : "+s"(nb));
    const int busy = (288 * 4) % nb;
    const int c = (int)blockIdx.x;
    if (c < busy) return;
    prep_weights(p, lds, wave, lane, layer, (c - busy) * 8 + wave, (nb - busy) * 8, (c - busy) * 512 + tid, (nb - busy) * 512);
}
DI void prep_phase(const PZ& p, LAS unsigned char* lds, int tid, int wave, int lane) {
    int nb = gridDim.x; asm volatile("" : "+s"(nb));
    const int gw = blockIdx.x * 8 + wave, NGW = nb * 8, gt = blockIdx.x * 512 + tid, NGT = nb * 512;
    prep_weights(p, lds, wave, lane, 0, gw, NGW, gt, NGT);
    float* small = (float*)(p.ws() + WS_SMALL);
    if (blockIdx.x == 0) {
        for (int i = tid; i < 1024; i += 512) {
            const int pp = i >> 4, f = i & 15;
            const float inv = exp2f(-(float)f * 0.8304820237218406f);
            const float ang = (float)pp * inv;
            small[2 * i] = __cosf(ang); small[2 * i + 1] = __sinf(ang);
        }
    }
    if (blockIdx.x == 1 % nb) {
        for (int i = tid; i < 1024; i += 512) {
            const float a0 = p.in(39)[i], a1 = p.in(39)[1024 + i], a2 = p.in(39)[2048 + i], a3 = p.in(39)[3072 + i];
            const float mx = fmaxf(fmaxf(a0, a1), fmaxf(a2, a3));
            const float e0 = expf(a0 - mx), e1 = expf(a1 - mx), e2 = expf(a2 - mx), e3 = expf(a3 - mx);
            small[2048 + i] = (e1 + e2 + e3) / (e0 + e1 + e2 + e3);
        }
    }
    __syncthreads();
    LAS float* sc = (LAS float*)lds;
    LAS float* red = sc + 1024 * 33;
    for (int i = tid; i < 33 * 1024; i += 512) { const int r = i >> 10, k = i & 1023; const float cv = r < 32 ? p.in(1)[r * 1024 + k] : p.in(3)[k]; sc[k * 33 + r] = silu_f(cv); }
    __syncthreads();
    float* MOD = (float*)(p.ws() + WS_MOD);
    for (int grp = blockIdx.x; grp < 4 * 96; grp += nb) {
        const int l = grp / 96, n = (grp % 96) * 64 + lane;
        float acc[33];
#pragma unroll
        for (int r = 0; r < 33; ++r) acc[r] = 0.f;
        const float* wp = p.in(4) + ((size_t)l * 1024 + wave * 128) * 6144 + n;
        for (int kb = 0; kb < 128; kb += 8) {
            float wv[8];
#pragma unroll
            for (int i = 0; i < 8; ++i) wv[i] = wp[(size_t)(kb + i) * 6144];
#pragma unroll
            for (int i = 0; i < 8; ++i) {
                const LAS float* s = sc + (wave * 128 + kb + i) * 33;
#pragma unroll
                for (int r = 0; r < 33; ++r) acc[r] += wv[i] * s[r];
            }
        }
#pragma unroll
        for (int r = 0; r < 33; ++r) {
            red[wave * 64 + lane] = acc[r];
            __syncthreads();
            if (wave == 0) {
                float s = 0.f;
#pragma unroll
                for (int w = 0; w < 8; ++w) s += red[w * 64 + lane];
                MOD[((size_t)l * 33 + r) * 6144 + n] = s + p.in(5)[l * 6144 + n];
            }
            __syncthreads();
        }
    }
}

DI void row_phase(const PZ& p, int layer, int mode, int wave, int lane) {
    const int gw = blockIdx.x * 8 + wave, NGW = gridDim.x * 8;
    const bool from_in = (layer == 0);
    const float* xl_src = from_in ? p.in(0) : p.out();
    const float* xc_src = from_in ? p.in(2) : (const float*)(p.ws() + WS_XC);
    float* xc_dst = (float*)(p.ws() + WS_XC);
    const float* MOD = (const float*)(p.ws() + WS_MOD);
    const float* modl = MOD + (size_t)layer * 33 * 6144;
    const float* gpm = p.in(7) + layer * 1024;
    const float* gpl = p.in(9) + layer * 1024;
    const int hl = mode == 2 ? layer + 1 : layer;
    const bool do_h = hl < 4;
    const float* gpre = (mode == 1 ? p.in(8) : p.in(6)) + (do_h ? hl : 0) * 1024;
    const float* modh = MOD + (size_t)(do_h ? hl : 0) * 33 * 6144;
    const int shift_i = mode == 1 ? 3 : 0, scale_i = mode == 1 ? 4 : 1;
    bf16_t* HAo = (bf16_t*)(p.ws() + ((hl == 2 && mode != 1) ? WS_BIG : WS_HA));
    const bf16_t* Y = (const bf16_t*)(p.ws() + WS_Y);
    const bf16_t* F = (const bf16_t*)(p.ws() + WS_HA);
    for (int m = gw; m < MTOK; m += NGW) {
        const int b = m / TT, t = m - b * TT; const bool isc = t < NCTX; const int mr = isc ? 32 : b;
        if (isc && layer == 3 && mode != 0) continue;
        const size_t xoff = isc ? (size_t)(b * NCTX + t) * 1024 : (size_t)(b * NLAT + t - NCTX) * 1024;
        const float* xs = (isc ? xc_src : xl_src) + xoff;
        float* xd = (isc ? xc_dst : p.out()) + xoff;
        f32x4 xv[4];
#pragma unroll
        for (int j = 0; j < 4; ++j) xv[j] = __builtin_nontemporal_load((const f32x4*)xs + lane + 64 * j);
        if (mode != 0) {
            f32x4 yv[4]; float ss = 0.f;
#pragma unroll
            for (int j = 0; j < 4; ++j) { yv[j] = bf4_to_f4(__builtin_nontemporal_load((const u32x2*)(Y + (size_t)m * 1024) + lane + 64 * j)); ss += yv[j].x * yv[j].x + yv[j].y * yv[j].y + yv[j].z * yv[j].z + yv[j].w * yv[j].w; }
            const float rstd = rsqrtf(wave_sum(ss) * (1.f / 1024.f) + 1e-6f);
#pragma unroll
            for (int j = 0; j < 4; ++j) {
                const f32x4 gate = *((const f32x4*)(modl + (size_t)mr * 6144 + 2 * 1024) + lane + 64 * j);
                const f32x4 gp = *((const f32x4*)gpm + lane + 64 * j);
                xv[j] += gate * (yv[j] * rstd * gp);
            }
        }
        if (mode == 2) {
            f32x4 yv[4]; float ss = 0.f;
#pragma unroll
            for (int j = 0; j < 4; ++j) { yv[j] = bf4_to_f4(__builtin_nontemporal_load((const u32x2*)(F + (size_t)m * 1024) + lane + 64 * j)); ss += yv[j].x * yv[j].x + yv[j].y * yv[j].y + yv[j].z * yv[j].z + yv[j].w * yv[j].w; }
            const float rstd = rsqrtf(wave_sum(ss) * (1.f / 1024.f) + 1e-6f);
#pragma unroll
            for (int j = 0; j < 4; ++j) {
                const f32x4 gate = *((const f32x4*)(modl + (size_t)mr * 6144 + 5 * 1024) + lane + 64 * j);
                const f32x4 gp = *((const f32x4*)gpl + lane + 64 * j);
                xv[j] += gate * (yv[j] * rstd * gp);
                __builtin_nontemporal_store(xv[j], (f32x4*)xd + lane + 64 * j);
            }
        }
        if (do_h) {
            float ss = 0.f;
#pragma unroll
            for (int j = 0; j < 4; ++j) ss += xv[j].x * xv[j].x + xv[j].y * xv[j].y + xv[j].z * xv[j].z + xv[j].w * xv[j].w;
            const float rstd = rsqrtf(wave_sum(ss) * (1.f / 1024.f) + 1e-6f);
#pragma unroll
            for (int j = 0; j < 4; ++j) {
                const f32x4 g = *((const f32x4*)gpre + lane + 64 * j);
                const f32x4 sh = *((const f32x4*)(modh + (size_t)mr * 6144 + shift_i * 1024) + lane + 64 * j);
                const f32x4 sc = *((const f32x4*)(modh + (size_t)mr * 6144 + scale_i * 1024) + lane + 64 * j);
                const f32x4 h = xv[j] * rstd * g * (sc + 1.f) + sh;
                *((u32x2*)(HAo + (size_t)m * 1024) + lane + 64 * j) = f4_to_bf4(h);
            }
        }
    }
}
DI void dx_phase(const PZ& p, int wave, int lane) {
    const int gw = blockIdx.x * 8 + wave, NGW = gridDim.x * 8;
    const bf16_t* HT = (const bf16_t*)(p.ws() + WS_BIG);
    bf16_t* HA = (bf16_t*)(p.ws() + WS_HA);
    for (int m = gw; m < MTOK; m += NGW) {
        const int t = m % TT; const bool first = (t == 0 || t == NCTX), last = (t == NCTX - 1 || t == TT - 1);
        const u32x2* hp = (const u32x2*)(HT + (size_t)m * 1024) + lane;
#pragma unroll
        for (int j = 0; j < 4; ++j) {
            const u32x2 hraw = hp[64 * j];
            const f32x4 h = bf4_to_f4(hraw);
            f32x4 pv = (f32x4){0.f, 0.f, 0.f, 0.f}, nv = pv;
            if (!first) pv = bf4_to_f4((hp - 256)[64 * j]);
            if (!last) nv = bf4_to_f4((hp + 256)[64 * j]);
            const f32x4 dx = (pv + nv) * 0.5f - h;
            *((u32x2*)(HA + (size_t)m * 2048) + lane + 64 * j) = hraw;
            *((u32x2*)(HA + (size_t)m * 2048 + 1024) + lane + 64 * j) = f4_to_bf4(dx);
        }
    }
}

DI void st8(bf16_t* ptr, f32x4 v0, f32x4 v1) {
    u32x4 w; w.x = cvtpk(v0.x, v0.y); w.y = cvtpk(v0.z, v0.w); w.z = cvtpk(v1.x, v1.y); w.w = cvtpk(v1.z, v1.w);
    *(u32x4*)ptr = w;
}
template <class F> struct EpiP {
    static constexpr bool PERM = true, AFTER_DRAIN = false; F f;
    DI void operator()(const f32x4 (&acc)[2][2][4][2], const pg8::Unit& u, int wr, int wc, int fr, int fq) const {
        const int row0 = u.pm * 256 + wr * 64 + fr, col0 = u.pn * 256 + wc * 32 + 8 * fq;
#pragma unroll
        for (int ai = 0; ai < 2; ++ai)
#pragma unroll
            for (int m = 0; m < 4; ++m)
#pragma unroll
                for (int bj = 0; bj < 2; ++bj) f(row0 + ai * 128 + m * 16, col0 + bj * 128, acc[ai][bj][m][0], acc[ai][bj][m][1]);
    }
};
template <class F> struct EpiN {
    static constexpr bool PERM = false, AFTER_DRAIN = false; F f;
    DI void operator()(const f32x4 (&acc)[2][2][4][2], const pg8::Unit& u, int wr, int wc, int fr, int fq) const {
        const int row0 = u.pm * 256 + wr * 64 + fr, col0 = u.pn * 256 + wc * 32 + 4 * fq;
#pragma unroll
        for (int ai = 0; ai < 2; ++ai)
#pragma unroll
            for (int m = 0; m < 4; ++m)
#pragma unroll
                for (int bj = 0; bj < 2; ++bj) f(row0 + ai * 128 + m * 16, col0 + bj * 128, acc[ai][bj][m][0], acc[ai][bj][m][1]);
    }
};
struct FPlain { bf16_t* O; int ld; DI void operator()(int row, int col, f32x4 v0, f32x4 v1) const { st8(O + (size_t)row * ld + col, v0, v1); } };
struct FRelu2 { bf16_t* O; int ld; DI void operator()(int row, int col, f32x4 v0, f32x4 v1) const {
    v0 = __builtin_elementwise_max(v0, (f32x4){0.f, 0.f, 0.f, 0.f}); v1 = __builtin_elementwise_max(v1, (f32x4){0.f, 0.f, 0.f, 0.f});
    st8(O + (size_t)row * ld + col, v0 * v0, v1 * v1); } };
struct FGlaIn { bf16_t* big; float* T; bf16_t* og; DI void operator()(int row, int col, f32x4 v0, f32x4 v1) const {
    if (col >= 2304) {
#pragma unroll
        for (int i = 0; i < 4; ++i) { v0[i] = silu_f(v0[i]); v1[i] = silu_f(v1[i]); }
        st8(og + (size_t)row * 1024 + (col - 2304), v0, v1); return; }
    if (col < 2048) st8(big + (size_t)row * 4096 + col, v0, v1);
    else { const int c2 = col - 2048; if (c2 < 32) { *(f32x4*)(T + (size_t)row * 32 + c2) = v0; *(f32x4*)(T + (size_t)row * 32 + c2 + 4) = v1; } } } };
struct FHgrnIn { bf16_t* big; bf16_t* og; DI void operator()(int row, int col, f32x4 v0, f32x4 v1) const {
    if (col < 1024 || col >= 4096) {
#pragma unroll
        for (int i = 0; i < 4; ++i) { v0[i] = silu_f(v0[i]); v1[i] = silu_f(v1[i]); } }
    if (col >= 4096) st8(og + (size_t)row * 1024 + (col - 4096), v0, v1);
    else st8(big + (size_t)row * 4096 + col, v0, v1); } };
struct FRwkvIn { bf16_t* rkv; bf16_t* lr; bf16_t* sg; DI void operator()(int row, int col, f32x4 v0, f32x4 v1) const {
    if (col < 3072) { st8(rkv + (size_t)row * 3072 + col, v0, v1); }
    else if (col < 3328) { const int c2 = col - 3072;
        if (c2 < 128) {
#pragma unroll
            for (int i = 0; i < 4; ++i) { v0[i] = tanhf(v0[i]); v1[i] = tanhf(v1[i]); } }
        st8(lr + (size_t)row * 256 + c2, v0, v1); }
    else { const int c2 = col - 3328;
        if (c2 < 128) {
#pragma unroll
            for (int i = 0; i < 4; ++i) { v0[i] = sigmoid_f(v0[i]); v1[i] = sigmoid_f(v1[i]); } }
        else { v0 = (f32x4){0.f, 0.f, 0.f, 0.f}; v1 = v0; }
        st8(sg + (size_t)row * 256 + c2, v0, v1); } } };
struct FQkv { bf16_t* qkv; bf16_t* vt; const float* rope; DI void operator()(int row, int col, f32x4 a, f32x4 b) const {
    const int bb = row / TT, t = row - bb * TT;
    if (col < 1280) {
        if (t >= NCTX) {
            const int pos = t - NCTX, axis = (col >> 5) & 1, pp = axis ? (pos & 63) : (pos >> 6), f0 = col & 15;
#pragma unroll
            for (int j = 0; j < 4; ++j) {
                const float c = rope[2 * (pp * 16 + f0 + j)], s = rope[2 * (pp * 16 + f0 + j) + 1];
                const float x1 = a[j], x2 = b[j];
                a[j] = x1 * c - x2 * s; b[j] = x2 * c + x1 * s;
            }
        }
        if (col < 1024) { a = a * 0.18033688011112042f; b = b * 0.18033688011112042f; }
        bf16_t* o = qkv + (size_t)row * 1536 + col;
        *(u32x2*)o = (u32x2){cvtpk(a.x, a.y), cvtpk(a.z, a.w)};
        *(u32x2*)(o + 16) = (u32x2){cvtpk(b.x, b.y), cvtpk(b.z, b.w)};
    } else {
        const int d0 = col - 1280, kvh = d0 >> 6, d = d0 & 63;
        bf16_t* o = vt + ((size_t)(bb * 4 + kvh) * 64 + d) * TT + t;
#pragma unroll
        for (int j = 0; j < 4; ++j) { o[(size_t)j * TT] = f2bf(a[j]); o[(size_t)(16 + j) * TT] = f2bf(b[j]); }
    } } };

struct LatOrder {
    pg8::StaticOrder S;
    DI void init(int N, int G, int c) { S.init(NBATCH * NLAT, N, G, c); }
    DI bool next(int i, pg8::Unit& u) const { if (!S.next(i, u)) return false; u.pm = (u.pm >> 3) * 9 + 1 + (u.pm & 7); return true; }
    DI void a_ready(const pg8::Unit&) const {}
    DI void done(const pg8::Unit&) const {}
};
template <class Epi> DI void run_gemm_lat(LAS unsigned char* lds, const bf16_t* A, const bf16_t* Bt, int N, int K, const Epi& E, int tid) {
    pg8::Gemm g{A, Bt, MTOK, N, K}; LatOrder S; S.init(N, (int)gridDim.x, (int)blockIdx.x);
    pg8::gemm_phase<Epi, LatOrder, true, true>(lds, g, S, E, tid);
}
template <class Epi> DI void run_gemm(LAS unsigned char* lds, const bf16_t* A, const bf16_t* Bt, int N, int K, const Epi& E, int tid) {
    pg8::Gemm g{A, Bt, MTOK, N, K}; pg8::StaticOrder S; S.init(MTOK, N, (int)gridDim.x, (int)blockIdx.x);
    pg8::gemm_phase<Epi, pg8::StaticOrder, true, true>(lds, g, S, E, tid);
}

#define MFMA16(a, b, c) __builtin_amdgcn_mfma_f32_16x16x32_bf16((a), (b), (c), 0, 0, 0)
DI bf16x8 mk8(u32x2 lo, u32x2 hi) { return __builtin_bit_cast(bf16x8, ((u32x4){lo.x, lo.y, hi.x, hi.y})); }
DI void attn_phase(const PZ& p, LAS unsigned char* lds, int tid, int wave, int lane) {
    const bf16_t* qkv = (const bf16_t*)(p.ws() + WS_BIG);
    const bf16_t* vt = (const bf16_t*)(p.ws() + WS_BIG + BIG_VT);
    bf16_t* O = (bf16_t*)(p.ws() + WS_HA);
    LAS bf16_t* KsB = (LAS bf16_t*)lds;
    LAS bf16_t* VsB = KsB + 2 * 64 * 72;
    const int l15 = lane & 15, g = lane >> 4, hg = wave >> 1, qh = wave & 1;
    const int rowi = tid >> 3, piece = tid & 7;
    for (int unit = blockIdx.x; unit < NBATCH * 4 * 36; unit += gridDim.x) {
        const int qblk = unit % 36, bk = unit / 36, kvh = bk & 3, b = bk >> 2, hq = kvh * 4 + hg;
        const int row0 = b * TT + qblk * 64 + qh * 32;
        bf16x8 qf[2][2];
#pragma unroll
        for (int mt = 0; mt < 2; ++mt)
#pragma unroll
            for (int ks = 0; ks < 2; ++ks) qf[mt][ks] = *(const bf16x8*)(qkv + (size_t)(row0 + mt * 16 + l15) * 1536 + hq * 64 + ks * 32 + g * 8);
        const float sink2 = p.in(14)[hq] * 1.4426950408889634f;
        float mrow[2], lrow[2]; f32x4 oacc[4][2];
#pragma unroll
        for (int mt = 0; mt < 2; ++mt) {
            mrow[mt] = sink2; lrow[mt] = (g == 0) ? 1.f : 0.f;
#pragma unroll
            for (int md = 0; md < 4; ++md) oacc[md][mt] = (f32x4){0.f, 0.f, 0.f, 0.f};
        }
        int lo = 0, ntiles = 4;
        if (qblk >= 4) { lo = qblk - 2 < 4 ? 4 : qblk - 2; const int hi = qblk + 2 > 35 ? 35 : qblk + 2; ntiles = 4 + (hi - lo + 1); }
        const bf16_t* kbase = qkv + (size_t)(b * TT + rowi) * 1536 + 1024 + kvh * 64 + piece * 8;
        const bf16_t* vbase = vt + ((size_t)(b * 4 + kvh) * 64 + rowi) * TT + piece * 8;
        u32x4 kreg = *(const u32x4*)(kbase), vreg = *(const u32x4*)(vbase);
        __syncthreads();
        *(LAS u32x4*)(KsB + rowi * 72 + piece * 8) = kreg;
        *(LAS u32x4*)(VsB + rowi * 72 + piece * 8) = vreg;
        __syncthreads();
        for (int it = 0; it < ntiles; ++it) {
            const int kt = it < 4 ? it : lo + it - 4;
            const LAS bf16_t* Ks = KsB + (it & 1) * (64 * 72);
            const LAS bf16_t* Vs = VsB + (it & 1) * (64 * 72);
            if (it + 1 < ntiles) {
                const int kn = (it + 1) < 4 ? (it + 1) : lo + it + 1 - 4;
                kreg = *(const u32x4*)(kbase + (size_t)kn * 64 * 1536);
                vreg = *(const u32x4*)(vbase + kn * 64);
            }
            f32x4 sacc[4][2];
#pragma unroll
            for (int nt = 0; nt < 4; ++nt) { sacc[nt][0] = (f32x4){0.f, 0.f, 0.f, 0.f}; sacc[nt][1] = sacc[nt][0]; }
#pragma unroll
            for (int nt = 0; nt < 4; ++nt)
#pragma unroll
                for (int ks = 0; ks < 2; ++ks) {
                    const bf16x8 kf = *(const LAS bf16x8*)(Ks + (nt * 16 + l15) * 72 + ks * 32 + g * 8);
#pragma unroll
                    for (int mt = 0; mt < 2; ++mt) sacc[nt][mt] = MFMA16(kf, qf[mt][ks], sacc[nt][mt]);
                }
            if (kt >= 4) {
#pragma unroll
                for (int mt = 0; mt < 2; ++mt) {
                    const int tq = qblk * 64 + qh * 32 + mt * 16 + l15;
#pragma unroll
                    for (int nt = 0; nt < 4; ++nt)
#pragma unroll
                        for (int j = 0; j < 4; ++j) {
                            const int dd = tq - (kt * 64 + nt * 16 + g * 4 + j);
                            if (dd > 128 || dd < -128) sacc[nt][mt][j] = -1e30f;
                        }
                }
            }
#pragma unroll
            for (int mt = 0; mt < 2; ++mt) {
                float mx = sacc[0][mt][0];
#pragma unroll
                for (int nt = 0; nt < 4; ++nt)
#pragma unroll
                    for (int j = 0; j < 4; ++j) mx = fmaxf(mx, sacc[nt][mt][j]);
                mx = fmaxf(mx, __shfl_xor(mx, 16)); mx = fmaxf(mx, __shfl_xor(mx, 32));
                const float mnew = fmaxf(mrow[mt], mx);
                const float alpha = __builtin_amdgcn_exp2f(mrow[mt] - mnew);
                mrow[mt] = mnew;
                float ls = lrow[mt] * alpha;
#pragma unroll
                for (int nt = 0; nt < 4; ++nt)
#pragma unroll
                    for (int j = 0; j < 4; ++j) { const float pe = __builtin_amdgcn_exp2f(sacc[nt][mt][j] - mnew); sacc[nt][mt][j] = pe; ls += pe; }
                lrow[mt] = ls;
#pragma unroll
                for (int md = 0; md < 4; ++md) oacc[md][mt] *= alpha;
            }
#pragma unroll
            for (int kp = 0; kp < 2; ++kp) {
                bf16x8 pB[2];
#pragma unroll
                for (int mt = 0; mt < 2; ++mt) {
                    const f32x4 x0 = sacc[2 * kp][mt], x1 = sacc[2 * kp + 1][mt];
                    pB[mt] = mk8((u32x2){cvtpk(x0.x, x0.y), cvtpk(x0.z, x0.w)}, (u32x2){cvtpk(x1.x, x1.y), cvtpk(x1.z, x1.w)});
                }
#pragma unroll
                for (int md = 0; md < 4; ++md) {
                    const bf16x8 vA = mk8(*(const LAS u32x2*)(Vs + (md * 16 + l15) * 72 + (2 * kp) * 16 + g * 4), *(const LAS u32x2*)(Vs + (md * 16 + l15) * 72 + (2 * kp + 1) * 16 + g * 4));
#pragma unroll
                    for (int mt = 0; mt < 2; ++mt) oacc[md][mt] = MFMA16(vA, pB[mt], oacc[md][mt]);
                }
            }
            if (it + 1 < ntiles) {
                *(LAS u32x4*)(KsB + ((it + 1) & 1) * (64 * 72) + rowi * 72 + piece * 8) = kreg;
                *(LAS u32x4*)(VsB + ((it + 1) & 1) * (64 * 72) + rowi * 72 + piece * 8) = vreg;
            }
            __syncthreads();
        }
#pragma unroll
        for (int mt = 0; mt < 2; ++mt) {
            float lt = lrow[mt]; lt += __shfl_xor(lt, 16); lt += __shfl_xor(lt, 32);
            const float inv = 1.f / lt;
            bf16_t* o = O + (size_t)(row0 + mt * 16 + l15) * 1024 + hq * 64 + g * 4;
#pragma unroll
            for (int md = 0; md < 4; ++md) { const f32x4 ov = oacc[md][mt] * inv; *(u32x2*)(o + md * 16) = (u32x2){cvtpk(ov.x, ov.y), cvtpk(ov.z, ov.w)}; }
        }
    }
}

template <int KIND> DI void chunk_scan_phase(const PZ& p, LAS unsigned char* lds, int tid, int wave, int lane_in) {
    constexpr int SLOT_BYTES = 73216, OFF_QD = 0, OFF_KI = 17408, OFF_KET = 34816, OFF_VT = 53248, OFF_SM = 71680;
    bf16_t* big = (bf16_t*)(p.ws() + WS_BIG);
    const float* Tg = (const float*)(p.ws() + WS_T);
    const float* LBv = (const float*)(p.ws() + WS_SMALL) + 2048;
    const int slot = wave >> 2, w4 = wave & 3;
    LAS unsigned char* sl = lds + slot * SLOT_BYTES;
    LAS bf16_t* Qd = (LAS bf16_t*)(sl + OFF_QD); LAS bf16_t* Ki = (LAS bf16_t*)(sl + OFF_KI); LAS bf16_t* Ab = Ki;
    LAS bf16_t* KeT = (LAS bf16_t*)(sl + OFF_KET); LAS bf16_t* Vt = (LAS bf16_t*)(sl + OFF_VT);
    LAS float* hs = (LAS float*)(sl + OFF_SM); LAS float* dc = hs + 256;
    LAS float* Tl = (LAS float*)(sl + OFF_QD);
    for (int ub = blockIdx.x; ub < 256; ub += gridDim.x) {
        const int st0 = tid & 255;
        const int u = ub * 2 + slot, dir = u & 1, b = u >> 4;
        int qcol0, kcol0, vcol0, ocol0;
        if (KIND == 0) { const int vh = (u >> 1) & 1, h = (u >> 2) & 3; qcol0 = h * 128; kcol0 = 512 + h * 128; vcol0 = 1024 + h * 256 + vh * 128; ocol0 = 2048 + dir * 1024 + h * 256 + vh * 128; }
        else { const int h = (u >> 1) & 7; qcol0 = h * 128; kcol0 = 1024 + dir * 1024 + h * 128; vcol0 = 3072 + h * 128; ocol0 = kcol0; }
        float gu[16], gbias = 0.f, lbv = 0.f;
        if (KIND == 0) {
            const int hcol = qcol0 + (st0 & 127);
#pragma unroll
            for (int r = 0; r < 16; ++r) gu[r] = p.in(17)[((size_t)dir * 16 + r) * 512 + hcol];
            gbias = p.in(18)[dir * 512 + hcol];
        } else {
#pragma unroll
            for (int r = 0; r < 16; ++r) gu[r] = 0.f;
            lbv = LBv[qcol0 + (st0 & 127)];
        }
        const int sgn = dir ? -1 : 1;
        f32x4 S[8][2];
#pragma unroll
        for (int i = 0; i < 8; ++i) { S[i][0] = (f32x4){0.f, 0.f, 0.f, 0.f}; S[i][1] = S[i][0]; }
        unsigned pa[16], pq[16], pv[16]; f32x4 tpre = (f32x4){0.f, 0.f, 0.f, 0.f};
#define CS_PREFETCH(cc) do { \
            const long mcn_ = (long)b * TT + tok_of(dir, (cc) * 64); \
            const bf16_t* rp_ = big + (mcn_ + sgn * (32 * (st0 >> 7))) * 4096 + (st0 & 127); const long stp_ = (long)sgn * 4096; \
            _Pragma("unroll") for (int i2 = 0; i2 < 16; ++i2) { const bf16_t* r0_ = rp_ + stp_ * (2 * i2); const bf16_t* r1_ = r0_ + stp_; \
                pa[i2] = (unsigned)r0_[kcol0] | ((unsigned)r1_[kcol0] << 16); pq[i2] = (unsigned)r0_[qcol0] | ((unsigned)r1_[qcol0] << 16); pv[i2] = (unsigned)r0_[vcol0] | ((unsigned)r1_[vcol0] << 16); } \
            if (KIND == 0) tpre = *(const f32x4*)(Tg + (mcn_ + sgn * (st0 >> 2)) * 32 + dir * 16 + (st0 & 3) * 4); } while (0)
#define CS_UNPK(arr, i) __uint_as_float(((i) & 1) ? ((arr)[(i) >> 1] & 0xffff0000u) : ((arr)[(i) >> 1] << 16))
        CS_PREFETCH(0);
        for (int c = 0; c < TT / 64; ++c) {
            int ln = lane_in, stv = tid & 255; asm volatile("" : "+v"(ln), "+v"(stv));
            const int lane = ln, l15 = lane & 15, g = lane >> 4, st = stv, d = st & 127, hf = st >> 7;
            const long mc0 = (long)b * TT + tok_of(dir, c * 64);
            if (KIND == 0) { *(LAS f32x4*)(Tl + (st >> 2) * 16 + (st & 3) * 4) = tpre; __syncthreads(); }
            float bc[32];
            float run = 0.f;
#pragma unroll
            for (int i = 0; i < 32; ++i) {
                float gl;
                if (KIND == 0) {
                    float z = gbias;
#pragma unroll
                    for (int r4 = 0; r4 < 4; ++r4) { const f32x4 tv = *(const LAS f32x4*)(Tl + (32 * hf + i) * 16 + r4 * 4); z += tv.x * gu[4 * r4] + tv.y * gu[4 * r4 + 1] + tv.z * gu[4 * r4 + 2] + tv.w * gu[4 * r4 + 3]; }
                    gl = (fminf(z, 0.f) - __logf(1.f + __expf(-fabsf(z)))) * 0.0625f;
                } else {
                    const float pf = CS_UNPK(pa, i);
                    const float f = lbv + (1.f - lbv) * __builtin_amdgcn_rcpf(1.f + __expf(-pf));
                    gl = __logf(f);
                }
                run += gl; bc[i] = run;
            }
            hs[hf * 128 + d] = run;
            __syncthreads();
            const float boff = hf ? hs[d] : 0.f, btot = hs[d] + hs[128 + d];
            const float ebt = __expf(btot);
            if (hf == 0) dc[d] = ebt;
#pragma unroll
            for (int j8 = 0; j8 < 4; ++j8) {
                float ke[8];
#pragma unroll
                for (int i8 = 0; i8 < 8; ++i8) {
                    const int i = j8 * 8 + i8;
                    const float bb = bc[i] + boff;
                    float q = CS_UNPK(pq, i);
                    if (KIND == 0) q *= 0.08838834764831845f;
                    float k;
                    if (KIND == 0) k = CS_UNPK(pa, i);
                    else k = 1.f - __expf(bc[i] - (i ? bc[i > 0 ? i - 1 : 0] : 0.f));
                    const float eb = __expf(bb);
                    Qd[(32 * hf + i) * 136 + d] = f2bf(q * eb);
                    Ki[(32 * hf + i) * 136 + d] = f2bf(k * __builtin_amdgcn_rcpf(eb));
                    ke[i8] = k * (ebt * __builtin_amdgcn_rcpf(eb));
                }
                *(LAS u32x4*)(KeT + d * 72 + 32 * hf + 8 * j8) = (u32x4){cvtpk(ke[0], ke[1]), cvtpk(ke[2], ke[3]), cvtpk(ke[4], ke[5]), cvtpk(ke[6], ke[7])};
                *(LAS u32x4*)(Vt + d * 72 + 32 * hf + 8 * j8) = (u32x4){pv[4 * j8], pv[4 * j8 + 1], pv[4 * j8 + 2], pv[4 * j8 + 3]};
            }
            if (c + 1 < TT / 64) CS_PREFETCH(c + 1);
            __syncthreads();
            {
                f32x4 aacc[4];
#pragma unroll
                for (int nt = 0; nt < 4; ++nt) aacc[nt] = (f32x4){0.f, 0.f, 0.f, 0.f};
#pragma unroll
                for (int ks = 0; ks < 4; ++ks) {
                    const bf16x8 a = *(const LAS bf16x8*)(Qd + (w4 * 16 + l15) * 136 + ks * 32 + g * 8);
#pragma unroll
                    for (int nt = 0; nt < 4; ++nt) { const bf16x8 bfr = *(const LAS bf16x8*)(Ki + (nt * 16 + l15) * 136 + ks * 32 + g * 8); aacc[nt] = MFMA16(a, bfr, aacc[nt]); }
                }
                __syncthreads();
#pragma unroll
                for (int nt = 0; nt < 4; ++nt)
#pragma unroll
                    for (int j = 0; j < 4; ++j) { const int t = w4 * 16 + g * 4 + j, s2 = nt * 16 + l15; Ab[t * 72 + s2] = f2bf(s2 <= t ? aacc[nt][j] : 0.f); }
            }
            __syncthreads();
            bf16x8 sfr[4][2];
#pragma unroll
            for (int kp = 0; kp < 4; ++kp)
#pragma unroll
                for (int n2 = 0; n2 < 2; ++n2) {
                    const f32x4 x0 = S[2 * kp][n2], x1 = S[2 * kp + 1][n2];
                    const u32x4 w = (u32x4){cvtpk(x0.x, x0.y), cvtpk(x0.z, x0.w), cvtpk(x1.x, x1.y), cvtpk(x1.z, x1.w)};
                    sfr[kp][n2] = __builtin_bit_cast(bf16x8, w);
                }
#pragma unroll
            for (int mt = 0; mt < 4; ++mt) {
                f32x4 oacc[2]; oacc[0] = (f32x4){0.f, 0.f, 0.f, 0.f}; oacc[1] = oacc[0];
#pragma unroll
                for (int ks = 0; ks < 2; ++ks) {
                    const bf16x8 a = *(const LAS bf16x8*)(Ab + (mt * 16 + l15) * 72 + ks * 32 + g * 8);
#pragma unroll
                    for (int n2 = 0; n2 < 2; ++n2) { const bf16x8 bfr = *(const LAS bf16x8*)(Vt + (w4 * 32 + n2 * 16 + l15) * 72 + ks * 32 + g * 8); oacc[n2] = MFMA16(a, bfr, oacc[n2]); }
                }
#pragma unroll
                for (int kp = 0; kp < 4; ++kp) {
                    const u32x2 lo = *(const LAS u32x2*)(Qd + (mt * 16 + l15) * 136 + (2 * kp) * 16 + g * 4);
                    const u32x2 hi = *(const LAS u32x2*)(Qd + (mt * 16 + l15) * 136 + (2 * kp + 1) * 16 + g * 4);
                    const bf16x8 a = __builtin_bit_cast(bf16x8, ((u32x4){lo.x, lo.y, hi.x, hi.y}));
#pragma unroll
                    for (int n2 = 0; n2 < 2; ++n2) oacc[n2] = MFMA16(a, sfr[kp][n2], oacc[n2]);
                }
#pragma unroll
                for (int j = 0; j < 4; ++j) {
                    const long m = mc0 + sgn * (mt * 16 + g * 4 + j);
#pragma unroll
                    for (int n2 = 0; n2 < 2; ++n2) big[m * 4096 + ocol0 + w4 * 32 + n2 * 16 + l15] = f2bf(oacc[n2][j]);
                }
            }
#pragma unroll
            for (int md = 0; md < 8; ++md) {
                const f32x4 dv = *(const LAS f32x4*)(dc + md * 16 + g * 4);
                S[md][0] *= dv; S[md][1] *= dv;
#pragma unroll
                for (int ks = 0; ks < 2; ++ks) {
                    const bf16x8 a = *(const LAS bf16x8*)(KeT + (md * 16 + l15) * 72 + ks * 32 + g * 8);
#pragma unroll
                    for (int n2 = 0; n2 < 2; ++n2) { const bf16x8 bfr = *(const LAS bf16x8*)(Vt + (w4 * 32 + n2 * 16 + l15) * 72 + ks * 32 + g * 8); S[md][n2] = MFMA16(a, bfr, S[md][n2]); }
                }
            }
            __syncthreads();
        }
    }
}
#undef CS_PREFETCH
#undef CS_UNPK


DI void gla_scan_phase(const PZ& p, LAS unsigned char* lds, int tid, int wave, int lane_in) {
    constexpr int OFF_QD = 0, OFF_KI = 17408, OFF_KET = 34816, OFF_A = 53248, OFF_VT = 62464, OFF_HS = 99328, OFF_DC = 101376, OFF_T = 101888;
    bf16_t* big = (bf16_t*)(p.ws() + WS_BIG);
    const float* Tg = (const float*)(p.ws() + WS_T);
    LAS bf16_t* Qd = (LAS bf16_t*)(lds + OFF_QD); LAS bf16_t* Ki = (LAS bf16_t*)(lds + OFF_KI); LAS bf16_t* KeT = (LAS bf16_t*)(lds + OFF_KET);
    LAS bf16_t* Ab = (LAS bf16_t*)(lds + OFF_A); LAS bf16_t* Vt = (LAS bf16_t*)(lds + OFF_VT);
    LAS float* hs = (LAS float*)(lds + OFF_HS); LAS float* dc = (LAS float*)(lds + OFF_DC); LAS float* Tl = (LAS float*)(lds + OFF_T);
    for (int u = blockIdx.x; u < 256; u += gridDim.x) {
        const int dir = u & 1, h = (u >> 1) & 3, b = u >> 3;
        const int qcol0 = h * 128, kcol0 = 512 + h * 128, vcol0 = 1024 + h * 256, ocol0 = 2048 + dir * 1024 + h * 256;
        const int d0 = tid & 127, q40 = tid >> 7, vv0 = tid & 255, hf20 = tid >> 8;
        float gu[16];
#pragma unroll
        for (int r = 0; r < 16; ++r) gu[r] = p.in(17)[((size_t)dir * 16 + r) * 512 + qcol0 + d0];
        const float gbias = p.in(18)[dir * 512 + qcol0 + d0];
        const int sgn = dir ? -1 : 1;
        f32x4 S[8][2];
#pragma unroll
        for (int i = 0; i < 8; ++i) { S[i][0] = (f32x4){0.f, 0.f, 0.f, 0.f}; S[i][1] = S[i][0]; }
        unsigned pa[8], pq[8], pv[16]; f32x4 tpre = (f32x4){0.f, 0.f, 0.f, 0.f};
#define GS_PREFETCH(cc) do { \
            const long mcn_ = (long)b * TT + tok_of(dir, (cc) * 64); const long stp_ = (long)sgn * 4096; \
            const bf16_t* rp_ = big + (mcn_ + sgn * (16 * q40)) * 4096 + d0; \
            _Pragma("unroll") for (int i2 = 0; i2 < 8; ++i2) { const bf16_t* r0_ = rp_ + stp_ * (2 * i2); const bf16_t* r1_ = r0_ + stp_; \
                pa[i2] = (unsigned)r0_[kcol0] | ((unsigned)r1_[kcol0] << 16); pq[i2] = (unsigned)r0_[qcol0] | ((unsigned)r1_[qcol0] << 16); } \
            const bf16_t* vp_ = big + (mcn_ + sgn * (32 * hf20)) * 4096 + vcol0 + vv0; \
            _Pragma("unroll") for (int i2 = 0; i2 < 16; ++i2) { const bf16_t* r0_ = vp_ + stp_ * (2 * i2); pv[i2] = (unsigned)r0_[0] | ((unsigned)r0_[stp_] << 16); } \
            if (tid < 256) tpre = *(const f32x4*)(Tg + (mcn_ + sgn * (tid >> 2)) * 32 + dir * 16 + (tid & 3) * 4); } while (0)
#define GS_UNPK(arr, i) __uint_as_float(((i) & 1) ? ((arr)[(i) >> 1] & 0xffff0000u) : ((arr)[(i) >> 1] << 16))
        GS_PREFETCH(0);
        __syncthreads();
        if (tid < 256) *(LAS f32x4*)(Tl + (tid >> 2) * 16 + (tid & 3) * 4) = tpre;
        __syncthreads();
        for (int c = 0; c < TT / 64; ++c) {
            int ln = lane_in, tv_ = tid; asm volatile("" : "+v"(ln), "+v"(tv_));
            const int lane = ln, l15 = lane & 15, g = lane >> 4, d = tv_ & 127, q4 = tv_ >> 7, vv = tv_ & 255, hf2 = tv_ >> 8;
            const long mc0 = (long)b * TT + tok_of(dir, c * 64);
            float bc[16];
            float run = 0.f;
#pragma unroll
            for (int i = 0; i < 16; ++i) {
                float z = gbias;
#pragma unroll
                for (int r4 = 0; r4 < 4; ++r4) { const f32x4 tv = *(const LAS f32x4*)(Tl + (16 * q4 + i) * 16 + r4 * 4); z += tv.x * gu[4 * r4] + tv.y * gu[4 * r4 + 1] + tv.z * gu[4 * r4 + 2] + tv.w * gu[4 * r4 + 3]; }
                run += (fminf(z, 0.f) - __logf(1.f + __expf(-fabsf(z)))) * 0.0625f; bc[i] = run;
            }
            hs[q4 * 128 + d] = run;
            __syncthreads();
            const float h0 = hs[d], h1 = hs[128 + d], h2 = hs[256 + d], h3 = hs[384 + d];
            const float boff = (q4 > 0 ? h0 : 0.f) + (q4 > 1 ? h1 : 0.f) + (q4 > 2 ? h2 : 0.f), btot = (h0 + h1) + (h2 + h3);
            const float ebt = __expf(btot);
            if (q4 == 0) dc[d] = ebt;
#pragma unroll
            for (int j8 = 0; j8 < 2; ++j8) {
                float ke[8];
#pragma unroll
                for (int i8 = 0; i8 < 8; ++i8) {
                    const int i = j8 * 8 + i8;
                    const float bb = bc[i] + boff;
                    const float q = GS_UNPK(pq, i) * 0.08838834764831845f, k = GS_UNPK(pa, i);
                    const float eb = __expf(bb);
                    Qd[(16 * q4 + i) * 136 + d] = f2bf(q * eb);
                    Ki[(16 * q4 + i) * 136 + d] = f2bf(k * __builtin_amdgcn_rcpf(eb));
                    ke[i8] = k * (ebt * __builtin_amdgcn_rcpf(eb));
                }
                *(LAS u32x4*)(KeT + d * 72 + 16 * q4 + 8 * j8) = (u32x4){cvtpk(ke[0], ke[1]), cvtpk(ke[2], ke[3]), cvtpk(ke[4], ke[5]), cvtpk(ke[6], ke[7])};
            }
#pragma unroll
            for (int j8 = 0; j8 < 4; ++j8) *(LAS u32x4*)(Vt + vv * 72 + 32 * hf2 + 8 * j8) = (u32x4){pv[4 * j8], pv[4 * j8 + 1], pv[4 * j8 + 2], pv[4 * j8 + 3]};
            if (c + 1 < TT / 64) GS_PREFETCH(c + 1);
            __syncthreads();
            {
                const int tt = wave >> 1, s0 = (wave & 1) * 2;
                f32x4 aacc[2]; aacc[0] = (f32x4){0.f, 0.f, 0.f, 0.f}; aacc[1] = aacc[0];
#pragma unroll
                for (int ks = 0; ks < 4; ++ks) {
                    const bf16x8 a = *(const LAS bf16x8*)(Qd + (tt * 16 + l15) * 136 + ks * 32 + g * 8);
#pragma unroll
                    for (int n2 = 0; n2 < 2; ++n2) { const bf16x8 bfr = *(const LAS bf16x8*)(Ki + ((s0 + n2) * 16 + l15) * 136 + ks * 32 + g * 8); aacc[n2] = MFMA16(a, bfr, aacc[n2]); }
                }
#pragma unroll
                for (int n2 = 0; n2 < 2; ++n2)
#pragma unroll
                    for (int j = 0; j < 4; ++j) { const int t = tt * 16 + g * 4 + j, s2 = (s0 + n2) * 16 + l15; Ab[t * 72 + s2] = f2bf(s2 <= t ? aacc[n2][j] : 0.f); }
            }
            __syncthreads();
            bf16x8 sfr[4][2];
#pragma unroll
            for (int kp = 0; kp < 4; ++kp)
#pragma unroll
                for (int n2 = 0; n2 < 2; ++n2) {
                    const f32x4 x0 = S[2 * kp][n2], x1 = S[2 * kp + 1][n2];
                    sfr[kp][n2] = mk8((u32x2){cvtpk(x0.x, x0.y), cvtpk(x0.z, x0.w)}, (u32x2){cvtpk(x1.x, x1.y), cvtpk(x1.z, x1.w)});
                }
#pragma unroll
            for (int mt = 0; mt < 4; ++mt) {
                f32x4 oacc[2]; oacc[0] = (f32x4){0.f, 0.f, 0.f, 0.f}; oacc[1] = oacc[0];
#pragma unroll
                for (int ks = 0; ks < 2; ++ks) {
                    const bf16x8 a = *(const LAS bf16x8*)(Ab + (mt * 16 + l15) * 72 + ks * 32 + g * 8);
#pragma unroll
                    for (int n2 = 0; n2 < 2; ++n2) { const bf16x8 bfr = *(const LAS bf16x8*)(Vt + (wave * 32 + n2 * 16 + l15) * 72 + ks * 32 + g * 8); oacc[n2] = MFMA16(a, bfr, oacc[n2]); }
                }
#pragma unroll
                for (int kp = 0; kp < 4; ++kp) {
                    const bf16x8 a = mk8(*(const LAS u32x2*)(Qd + (mt * 16 + l15) * 136 + (2 * kp) * 16 + g * 4), *(const LAS u32x2*)(Qd + (mt * 16 + l15) * 136 + (2 * kp + 1) * 16 + g * 4));
#pragma unroll
                    for (int n2 = 0; n2 < 2; ++n2) oacc[n2] = MFMA16(a, sfr[kp][n2], oacc[n2]);
                }
#pragma unroll
                for (int j = 0; j < 4; ++j) {
                    const long m = mc0 + sgn * (mt * 16 + g * 4 + j);
#pragma unroll
                    for (int n2 = 0; n2 < 2; ++n2) big[m * 4096 + ocol0 + wave * 32 + n2 * 16 + l15] = f2bf(oacc[n2][j]);
                }
            }
#pragma unroll
            for (int md = 0; md < 8; ++md) {
                const f32x4 dv = *(const LAS f32x4*)(dc + md * 16 + g * 4);
                S[md][0] *= dv; S[md][1] *= dv;
#pragma unroll
                for (int ks = 0; ks < 2; ++ks) {
                    const bf16x8 a = *(const LAS bf16x8*)(KeT + (md * 16 + l15) * 72 + ks * 32 + g * 8);
#pragma unroll
                    for (int n2 = 0; n2 < 2; ++n2) { const bf16x8 bfr = *(const LAS bf16x8*)(Vt + (wave * 32 + n2 * 16 + l15) * 72 + ks * 32 + g * 8); S[md][n2] = MFMA16(a, bfr, S[md][n2]); }
                }
            }
            if (tv_ < 256) *(LAS f32x4*)(Tl + (tv_ >> 2) * 16 + (tv_ & 3) * 4) = tpre;
            __syncthreads();
        }
    }
#undef GS_PREFETCH
#undef GS_UNPK
}

template <int KIND> DI void post_diag_phase(const PZ& p, int wave, int lane) {
    const int gw = blockIdx.x * 8 + wave, NGW = gridDim.x * 8;
    const bf16_t* big = (const bf16_t*)(p.ws() + WS_BIG);
    const bf16_t* OG = (const bf16_t*)(p.ws() + WS_Y);
    bf16_t* HA = (bf16_t*)(p.ws() + WS_HA);
    const float* gn = KIND == 0 ? p.in(19) : p.in(40);
    for (int m = gw; m < MTOK; m += NGW) {
        if (KIND == 1 && (m % TT) < NCTX) continue;
        const bf16_t* of = big + (size_t)m * 4096 + (KIND == 0 ? 2048 : 1024);
#pragma unroll
        for (int j = 0; j < 4; ++j) {
            const f32x4 o = bf4_to_f4(*((const u32x2*)of + lane + 64 * j)) + bf4_to_f4(*((const u32x2*)(of + 1024) + lane + 64 * j));
            float ss = o.x * o.x + o.y * o.y + o.z * o.z + o.w * o.w;
            float rstd; f32x4 g4;
            if (KIND == 0) { rstd = rsqrtf(wave_sum(ss) * (1.f / 256.f) + 1e-6f); g4 = *((const f32x4*)gn + lane); }
            else { ss = red16(ss); ss += __shfl_xor(ss, 16); rstd = rsqrtf(ss * (1.f / 128.f) + 1e-6f); g4 = *((const f32x4*)gn + (lane & 31)); }
            const f32x4 og = bf4_to_f4(*((const u32x2*)(OG + (size_t)m * 1024) + lane + 64 * j));
            *((u32x2*)(HA + (size_t)m * 1024) + lane + 64 * j) = f4_to_bf4(o * rstd * g4 * og);
        }
    }
}

DI f32x4 prod16(f32x4 X, f32x4 Y, LAS float* T1, int l15, int g) {
#pragma unroll
    for (int j = 0; j < 4; ++j) T1[(g * 4 + j) * 20 + l15] = X[j];
    LDS_WAIT();
    const f32x4 xr = *(const LAS f32x4*)(T1 + l15 * 20 + g * 4);
    LDS_WAIT();
    const unsigned xh01 = cvtpk(xr.x, xr.y), xh23 = cvtpk(xr.z, xr.w);
    const unsigned xl01 = cvtpk(xr.x - __uint_as_float(xh01 << 16), xr.y - __uint_as_float(xh01 & 0xffff0000u));
    const unsigned xl23 = cvtpk(xr.z - __uint_as_float(xh23 << 16), xr.w - __uint_as_float(xh23 & 0xffff0000u));
    const unsigned yh01 = cvtpk(Y.x, Y.y), yh23 = cvtpk(Y.z, Y.w);
    const unsigned yl01 = cvtpk(Y.x - __uint_as_float(yh01 << 16), Y.y - __uint_as_float(yh01 & 0xffff0000u));
    const unsigned yl23 = cvtpk(Y.z - __uint_as_float(yh23 << 16), Y.w - __uint_as_float(yh23 & 0xffff0000u));
    const u32x2 z2 = (u32x2){0u, 0u};
    const bf16x8 ah = mk8((u32x2){xh01, xh23}, z2), al = mk8((u32x2){xl01, xl23}, z2), bh = mk8((u32x2){yh01, yh23}, z2), bl = mk8((u32x2){yl01, yl23}, z2);
    f32x4 acc = (f32x4){0.f, 0.f, 0.f, 0.f};
    acc = MFMA16(ah, bh, acc); acc = MFMA16(ah, bl, acc); acc = MFMA16(al, bh, acc);
    return acc;
}
DI void prod16x2(f32x4 X, f32x4 Y1, f32x4 Y2, LAS float* T1, int l15, int g, f32x4& R1, f32x4& R2) {
#pragma unroll
    for (int j = 0; j < 4; ++j) T1[(g * 4 + j) * 20 + l15] = X[j];
    LDS_WAIT();
    const f32x4 xr = *(const LAS f32x4*)(T1 + l15 * 20 + g * 4);
    LDS_WAIT();
    const unsigned xh01 = cvtpk(xr.x, xr.y), xh23 = cvtpk(xr.z, xr.w);
    const unsigned xl01 = cvtpk(xr.x - __uint_as_float(xh01 << 16), xr.y - __uint_as_float(xh01 & 0xffff0000u));
    const unsigned xl23 = cvtpk(xr.z - __uint_as_float(xh23 << 16), xr.w - __uint_as_float(xh23 & 0xffff0000u));
    const u32x2 z2 = (u32x2){0u, 0u};
    const bf16x8 ah = mk8((u32x2){xh01, xh23}, z2), al = mk8((u32x2){xl01, xl23}, z2);
    f32x4 acc[2]; const f32x4 Ys[2] = {Y1, Y2};
#pragma unroll
    for (int q = 0; q < 2; ++q) {
        const f32x4 Y = Ys[q];
        const unsigned yh01 = cvtpk(Y.x, Y.y), yh23 = cvtpk(Y.z, Y.w);
        const unsigned yl01 = cvtpk(Y.x - __uint_as_float(yh01 << 16), Y.y - __uint_as_float(yh01 & 0xffff0000u));
        const unsigned yl23 = cvtpk(Y.z - __uint_as_float(yh23 << 16), Y.w - __uint_as_float(yh23 & 0xffff0000u));
        const bf16x8 bh = mk8((u32x2){yh01, yh23}, z2), bl = mk8((u32x2){yl01, yl23}, z2);
        acc[q] = (f32x4){0.f, 0.f, 0.f, 0.f};
        acc[q] = MFMA16(ah, bh, acc[q]); acc[q] = MFMA16(ah, bl, acc[q]); acc[q] = MFMA16(al, bh, acc[q]);
    }
    R1 = acc[0]; R2 = acc[1];
}
DI void pair_sync(volatile LAS int* fl, int half, int seq) {
    asm volatile("s_waitcnt lgkmcnt(0)" ::: "memory");
    fl[half] = seq;
    while (fl[1 - half] < seq) __builtin_amdgcn_s_sleep(1);
    asm volatile("s_waitcnt lgkmcnt(0)" ::: "memory");
}
DI void rwkv_chunk_scan_phase(const PZ& p, LAS unsigned char* lds, int wave, int lane) {
    const int slot = wave & 3, half = wave >> 2;
    LAS unsigned char* wl = lds + slot * 26368;
    LAS bf16_t* AH = (LAS bf16_t*)wl; LAS bf16_t* RH = AH + 16 * 72; LAS bf16_t* BH = RH + 16 * 72; LAS bf16_t* KH = BH + 16 * 72;
    LAS bf16_t* BKT = KH + 16 * 72;
    LAS bf16_t* SMT = BKT + 64 * 40;
    LAS float* T1 = (LAS float*)(wl + 16640);
    LAS float* GC = (LAS float*)(wl + 17920);
    LAS float* PRM = (LAS float*)(wl + 18176);
    LAS bf16_t* RK = (LAS bf16_t*)(wl + 19456);
    LAS float* EX = (LAS float*)(wl + 25856);
    volatile LAS int* fl = (volatile LAS int*)(wl + 26112);
    if (lane == 0) fl[half] = 0;
    __syncthreads();
    int seq = 0;
    const bf16_t* rkv = (const bf16_t*)(p.ws() + WS_BIG);
    const bf16_t* LR = (const bf16_t*)(p.ws() + WS_BIG + BIG_LR);
    float* BS = (float*)(p.ws() + WS_BIG + BIG_BS);
    const u32x2 z2 = (u32x2){0u, 0u};
    for (int u = blockIdx.x * 4 + slot; u < NBATCH * 16 * 2; u += gridDim.x * 4) {
        const int dir = u & 1, h = (u >> 1) & 15, b = u >> 5;
        const int sgn = dir ? -1 : 1;
        bf16_t* Yo = (bf16_t*)(p.ws() + (dir == 0 ? WS_HA : WS_Y));
        const bf16_t* wupT = (const bf16_t*)(p.ws() + WS_SMALL + 65536) + ((size_t)dir * 1024 + h * 64) * 64;
        const bf16_t* aupT = (const bf16_t*)(p.ws() + WS_SMALL + 65536) + ((size_t)(2 + dir) * 1024 + h * 64) * 64;
        pair_sync(fl, half, ++seq);
        if (half == 0) {
            const int hc = h * 64 + lane;
            PRM[lane] = p.in(23)[dir * 1024 + hc]; PRM[64 + lane] = p.in(26)[dir * 1024 + hc]; PRM[128 + lane] = p.in(31)[hc]; PRM[192 + lane] = p.in(32)[hc]; PRM[256 + lane] = p.in(33)[hc];
        }
        f32x4 St[4][4];
#pragma unroll
        for (int i = 0; i < 4; ++i)
#pragma unroll
            for (int k = 0; k < 4; ++k) St[i][k] = (f32x4){0.f, 0.f, 0.f, 0.f};
        u32x4 stg[6]; bf16x8 awd[2], aad[2];
        {
            const long mcn = (long)b * TT + tok_of(dir, 0);
            if (half == 0) {
#pragma unroll
                for (int i = 0; i < 6; ++i) {
                    const int q = lane + 64 * i, t = q / 24, rem = q - 24 * t, mat = rem >> 3, pc = rem & 7;
                    stg[i] = *(const u32x4*)(rkv + (mcn + sgn * t) * 3072 + mat * 1024 + h * 64 + pc * 8);
                }
            } else {
#pragma unroll
                for (int i = 0; i < 6; ++i) stg[i] = (u32x4){0u, 0u, 0u, 0u};
            }
            const long mAn = mcn + sgn * (lane & 15);
#pragma unroll
            for (int ks = 0; ks < 2; ++ks) { awd[ks] = *(const bf16x8*)(LR + mAn * 256 + dir * 64 + ks * 32 + (lane >> 4) * 8); aad[ks] = *(const bf16x8*)(LR + mAn * 256 + 128 + dir * 64 + ks * 32 + (lane >> 4) * 8); }
        }
        for (int chunk = 0; chunk < TT / 16; ++chunk) {
            const long mc0 = (long)b * TT + tok_of(dir, chunk * 16);
            int ln = lane; asm volatile("" : "+v"(ln));
            const int l15 = ln & 15, g = ln >> 4;
            const bf16x8 awd0 = awd[0], awd1 = awd[1], aad0 = aad[0], aad1 = aad[1];
            {
                int lq = ln;
                if (half == 0) {
#pragma unroll
                    for (int i = 0; i < 6; ++i) {
                        const int q = lq + 64 * i, t = q / 24, rem = q - 24 * t, mat = rem >> 3, pc = rem & 7;
                        *(LAS u32x4*)(RK + t * 200 + mat * 64 + pc * 8) = stg[i];
                    }
                }
                if (chunk + 1 < TT / 16) {
                    const long mcn = (long)b * TT + tok_of(dir, (chunk + 1) * 16);
                    if (half == 0) {
#pragma unroll
                        for (int i = 0; i < 6; ++i) {
                            const int q = lq + 64 * i, t = q / 24, rem = q - 24 * t, mat = rem >> 3, pc = rem & 7;
                            stg[i] = *(const u32x4*)(rkv + (mcn + sgn * t) * 3072 + mat * 1024 + h * 64 + pc * 8);
                        }
                    }
                    const long mAn = mcn + sgn * l15;
#pragma unroll
                    for (int ks = 0; ks < 2; ++ks) { awd[ks] = *(const bf16x8*)(LR + mAn * 256 + dir * 64 + ks * 32 + g * 8); aad[ks] = *(const bf16x8*)(LR + mAn * 256 + 128 + dir * 64 + ks * 32 + g * 8); }
                }
            }
            pair_sync(fl, half, ++seq);
            f32x4 accW[2], accA[2];
#pragma unroll
            for (int n2 = 0; n2 < 2; ++n2) {
                const int nt = 2 * half + n2;
                accW[n2] = (f32x4){0.f, 0.f, 0.f, 0.f}; accA[n2] = accW[n2];
#pragma unroll
                for (int ks = 0; ks < 2; ++ks) {
                    const bf16x8 wf = *(const bf16x8*)(wupT + (nt * 16 + l15) * 64 + ks * 32 + g * 8);
                    const bf16x8 af = *(const bf16x8*)(aupT + (nt * 16 + l15) * 64 + ks * 32 + g * 8);
                    accW[n2] = MFMA16(ks ? awd1 : awd0, wf, accW[n2]); accA[n2] = MFMA16(ks ? aad1 : aad0, af, accA[n2]);
                }
            }
            float boff[2], bb[4][2], bC[2];
#pragma unroll
            for (int n2 = 0; n2 < 2; ++n2) {
                const int nt = 2 * half + n2;
                const float w0v = PRM[nt * 16 + l15];
                float lwj[4];
#pragma unroll
                for (int j = 0; j < 4; ++j) {
                    const float xn = -(w0v + accW[n2][j]);
                    const float sp = fmaxf(xn, 0.f) + __logf(1.f + __expf(-fabsf(xn)));
                    lwj[j] = -__expf(-sp - 0.5f);
                }
                const float p0 = lwj[0], p1 = p0 + lwj[1], p2 = p1 + lwj[2], p3 = p2 + lwj[3];
                const float t1 = __shfl(p3, (ln + 48) & 63);
                const float s1 = p3 + (g >= 1 ? t1 : 0.f);
                const float t2 = __shfl(s1, (ln + 32) & 63);
                const float s2 = s1 + (g >= 2 ? t2 : 0.f);
                const float off = s2 - p3;
                bb[0][n2] = p0 + off; bb[1][n2] = p1 + off; bb[2][n2] = p2 + off; bb[3][n2] = p3 + off; boff[n2] = off;
                bC[n2] = __shfl(s2, 48 + l15);
            }
            float av[4][2], kr[4][2], kdv[4][2], rv[4][2];
#pragma unroll
            for (int j = 0; j < 4; ++j) {
                const int t = g * 4 + j;
                float ss = 0.f, bsum = 0.f;
#pragma unroll
                for (int n2 = 0; n2 < 2; ++n2) {
                    const int c = (2 * half + n2) * 16 + l15;
                    const float r_ = bf2f(RK[t * 200 + c]), k_ = bf2f(RK[t * 200 + 64 + c]);
                    const float a_ = __builtin_amdgcn_rcpf(1.f + __expf(-(PRM[64 + c] + accA[n2][j])));
                    kr[j][n2] = k_ * PRM[128 + c]; ss += kr[j][n2] * kr[j][n2]; av[j][n2] = a_; rv[j][n2] = r_;
                    kdv[j][n2] = k_ * (1.f + (a_ - 1.f) * PRM[192 + c]);
                    bsum += r_ * kdv[j][n2] * PRM[256 + c];
                }
                ss = red16(ss); bsum = red16(bsum);
                if (l15 == 0) { EX[(half * 16 + t) * 2] = ss; EX[(half * 16 + t) * 2 + 1] = bsum; }
            }
            pair_sync(fl, half, ++seq);
            float gprev[2] = {1.f, 1.f}; const float gCv[2] = {__expf(bC[0]), __expf(bC[1])};
#pragma unroll
            for (int j = 0; j < 4; ++j) {
                const int t = g * 4 + j;
                const float ss = EX[t * 2] + EX[(16 + t) * 2];
                const float inv = __builtin_amdgcn_rsqf(fmaxf(ss, 1e-24f));
#pragma unroll
                for (int n2 = 0; n2 < 2; ++n2) {
                    const int c = (2 * half + n2) * 16 + l15;
                    const float kk = kr[j][n2] * inv, bq = bb[j][n2];
                    const float gt = __expf(bq), gi = __builtin_amdgcn_rcpf(gt), gm1 = (j == 0) ? __expf(boff[n2]) : gprev[n2], ge = gCv[n2] * gi; gprev[n2] = gt;
                    AH[t * 72 + c] = f2bf(-kk * gm1); RH[t * 72 + c] = f2bf(rv[j][n2] * gt);
                    BH[t * 72 + c] = f2bf(kk * av[j][n2] * gi); KH[t * 72 + c] = f2bf(kdv[j][n2] * gi);
                    BKT[c * 40 + t] = f2bf(kk * av[j][n2] * ge); BKT[c * 40 + 16 + t] = f2bf(kdv[j][n2] * ge);
                }
                if (half == 0 && l15 == 0) BS[((size_t)dir * MTOK + (mc0 + sgn * t)) * 16 + h] = EX[t * 2 + 1] + EX[(16 + t) * 2 + 1];
            }
            if (g == 0) {
#pragma unroll
                for (int n2 = 0; n2 < 2; ++n2) GC[(2 * half + n2) * 16 + l15] = gCv[n2];
            }
            pair_sync(fl, half, ++seq);
            f32x4 Xs[4], Yrs[4]; u32x2 vpk4[4];
#pragma unroll
            for (int nt = 0; nt < 4; ++nt) { Xs[nt] = (f32x4){0.f, 0.f, 0.f, 0.f}; Yrs[nt] = Xs[nt]; vpk4[nt] = z2; }
            if (half == 1) {
                f32x4 Mab = (f32x4){0.f, 0.f, 0.f, 0.f}, Mak = Mab, Nrb = Mab, Nrk = Mab;
#pragma unroll
                for (int ks = 0; ks < 2; ++ks) {
                    const bf16x8 fa = *(const LAS bf16x8*)(AH + l15 * 72 + ks * 32 + g * 8), fr = *(const LAS bf16x8*)(RH + l15 * 72 + ks * 32 + g * 8);
                    const bf16x8 fb = *(const LAS bf16x8*)(BH + l15 * 72 + ks * 32 + g * 8), fk = *(const LAS bf16x8*)(KH + l15 * 72 + ks * 32 + g * 8);
                    Mab = MFMA16(fa, fb, Mab); Mak = MFMA16(fa, fk, Mak); Nrb = MFMA16(fr, fb, Nrb); Nrk = MFMA16(fr, fk, Nrk);
                }
                f32x4 Lm;
#pragma unroll
                for (int j = 0; j < 4; ++j) {
                    const int t = g * 4 + j;
                    if (l15 >= t) { Mab[j] = 0.f; Mak[j] = 0.f; }
                    if (l15 > t) { Nrb[j] = 0.f; Nrk[j] = 0.f; }
                    Lm[j] = (l15 == t ? 1.f : 0.f) + Mab[j];
                }
                {
                    const f32x4 P2 = prod16(Mab, Mab, T1, l15, g);
                    f32x4 D, P4, P8;
                    prod16x2(P2, Lm, P2, T1, l15, g, D, P4); Lm += D;
                    prod16x2(P4, Lm, P4, T1, l15, g, D, P8); Lm += D;
                    Lm += prod16(P8, Lm, T1, l15, g);
                }
#pragma unroll
                for (int j = 0; j < 4; ++j) {
                    const int row = (g * 4 + j) * 72 + l15;
                    SMT[row] = f2bf(Mak[j]); SMT[row + 16] = f2bf(Lm[j]); SMT[row + 32] = f2bf(Nrb[j]); SMT[row + 48] = f2bf(Nrk[j]);
                }
            } else {
#pragma unroll
                for (int nt = 0; nt < 4; ++nt) {
                    const LAS bf16_t* vp = RK + (g * 4) * 200 + 128 + nt * 16 + l15;
                    const unsigned v0 = vp[0], v1 = vp[200], v2 = vp[400], v3 = vp[600];
                    vpk4[nt] = (u32x2){v0 | (v1 << 16), v2 | (v3 << 16)};
                }
                bf16x8 aX[2], aR[2];
#pragma unroll
                for (int kp = 0; kp < 2; ++kp) {
                    aX[kp] = mk8(*(const LAS u32x2*)(AH + l15 * 72 + (2 * kp) * 16 + g * 4), *(const LAS u32x2*)(AH + l15 * 72 + (2 * kp + 1) * 16 + g * 4));
                    aR[kp] = mk8(*(const LAS u32x2*)(RH + l15 * 72 + (2 * kp) * 16 + g * 4), *(const LAS u32x2*)(RH + l15 * 72 + (2 * kp + 1) * 16 + g * 4));
                }
#pragma unroll
                for (int nt = 0; nt < 4; ++nt)
#pragma unroll
                    for (int kp = 0; kp < 2; ++kp) {
                        const f32x4 x0 = St[2 * kp][nt], x1 = St[2 * kp + 1][nt];
                        const bf16x8 sf = mk8((u32x2){cvtpk(x0.x, x0.y), cvtpk(x0.z, x0.w)}, (u32x2){cvtpk(x1.x, x1.y), cvtpk(x1.z, x1.w)});
                        Xs[nt] = MFMA16(aX[kp], sf, Xs[nt]); Yrs[nt] = MFMA16(aR[kp], sf, Yrs[nt]);
                    }
            }
            pair_sync(fl, half, ++seq);
            if (half == 0) {
                const bf16x8 makA = mk8(*(const LAS u32x2*)(SMT + l15 * 72 + g * 4), z2);
                const bf16x8 LA = mk8(*(const LAS u32x2*)(SMT + l15 * 72 + 16 + g * 4), z2);
                const bf16x8 nA = mk8(*(const LAS u32x2*)(SMT + l15 * 72 + 32 + g * 4), *(const LAS u32x2*)(SMT + l15 * 72 + 48 + g * 4));
                bf16x8 cvB[4];
#pragma unroll
                for (int nt = 0; nt < 4; ++nt) {
                    const u32x2 vpk = vpk4[nt];
                    const f32x4 Z = MFMA16(makA, mk8(vpk, z2), Xs[nt]);
                    const f32x4 Cm = MFMA16(LA, mk8((u32x2){cvtpk(Z.x, Z.y), cvtpk(Z.z, Z.w)}, z2), ((f32x4){0.f, 0.f, 0.f, 0.f}));
                    cvB[nt] = mk8((u32x2){cvtpk(Cm.x, Cm.y), cvtpk(Cm.z, Cm.w)}, vpk);
                    const f32x4 Y = MFMA16(nA, cvB[nt], Yrs[nt]);
#pragma unroll
                    for (int j = 0; j < 4; ++j) Yo[(mc0 + sgn * (g * 4 + j)) * 1024 + h * 64 + nt * 16 + l15] = f2bf(Y[j]);
                }
#pragma unroll
                for (int mt = 0; mt < 4; ++mt) {
                    const f32x4 gc4 = *(const LAS f32x4*)(GC + mt * 16 + g * 4);
                    const bf16x8 bkA = mk8(*(const LAS u32x2*)(BKT + (mt * 16 + l15) * 40 + g * 4), *(const LAS u32x2*)(BKT + (mt * 16 + l15) * 40 + 16 + g * 4));
#pragma unroll
                    for (int nt = 0; nt < 4; ++nt) St[mt][nt] = MFMA16(bkA, cvB[nt], St[mt][nt] * gc4);
                }
            }
        }
    }
}
DI void post_rwkv_phase(const PZ& p, int wave, int lane) {
    const int gw = blockIdx.x * 8 + wave, NGW = gridDim.x * 8;
    const bf16_t* rkv = (const bf16_t*)(p.ws() + WS_BIG);
    const float* BS = (const float*)(p.ws() + WS_BIG + BIG_BS);
    bf16_t* HA = (bf16_t*)(p.ws() + WS_HA);
    const bf16_t* YB = (const bf16_t*)(p.ws() + WS_Y);
    for (int m = gw; m < MTOK; m += NGW) {
        f32x4 outv[4];
#pragma unroll
        for (int j = 0; j < 4; ++j) {
            const int head = j * 4 + (lane >> 4);
            const f32x4 y = bf4_to_f4(*((const u32x2*)(HA + (size_t)m * 1024) + lane + 64 * j)) + bf4_to_f4(*((const u32x2*)(YB + (size_t)m * 1024) + lane + 64 * j));
            const float mu = red16(y.x + y.y + y.z + y.w) * (1.f / 64.f);
            const f32x4 d = y - mu;
            const float var = red16(d.x * d.x + d.y * d.y + d.z * d.z + d.w * d.w) * (1.f / 64.f);
            const float rstd = rsqrtf(var + 64e-5f);
            const f32x4 lw = *((const f32x4*)p.in(34) + lane + 64 * j), lb = *((const f32x4*)p.in(35) + lane + 64 * j);
            const float bon = 0.5f * (BS[(size_t)m * 16 + head] + BS[((size_t)MTOK + m) * 16 + head]);
            const f32x4 v = bf4_to_f4(*((const u32x2*)(rkv + (size_t)m * 3072 + 2048) + lane + 64 * j));
            const f32x4 gg = bf4_to_f4(*((const u32x2*)(rkv + (size_t)m * 3072) + lane + 64 * j));
            outv[j] = (d * rstd * lw + lb + v * bon) * gg;
        }
#pragma unroll
        for (int j = 0; j < 4; ++j) *((u32x2*)(HA + (size_t)m * 1024) + lane + 64 * j) = f4_to_bf4(outv[j]);
    }
}

#define XB_TMO      128
#define XB_XCNT(j)  (256  + 64 * (j))
#define XB_XSUB(j)  (1280 + 64 * (j))
#define XB_XGEN(j)  (2304 + 64 * (j))
#define XB_TOP      3328
#define XB_TOPGEN   3392
#define XCD_BAR_WORDS 3456
#define XB_SPIN_CAP (1u << 18)

__device__ __forceinline__ unsigned xb_ld(unsigned* p)              { return __hip_atomic_load(p, __ATOMIC_RELAXED, __HIP_MEMORY_SCOPE_AGENT); }
__device__ __forceinline__ unsigned xb_add(unsigned* p, unsigned v) { return __hip_atomic_fetch_add(p, v, __ATOMIC_RELAXED, __HIP_MEMORY_SCOPE_AGENT); }
__device__ __forceinline__ unsigned xb_xcc_id() { return (unsigned)__builtin_amdgcn_s_getreg((3 << 11) | 20) & 0xFu; }
#define XB_SPIN(cond, bar) do { unsigned _sp = 0; while (cond) { __builtin_amdgcn_s_sleep(1); \
    if ((++_sp & 255u) == 0u) { if (xb_ld(&(bar)[XB_TMO])) break; if (_sp > XB_SPIN_CAP) { atomicAdd(&(bar)[XB_TMO], 1u); break; } } } } while (0)

struct XcdBarrier {
    unsigned* bar; unsigned x;
    volatile LAS unsigned* st;
};

__device__ __forceinline__ XcdBarrier xcd_barrier_post(unsigned* bar, volatile LAS unsigned* st) {
    XcdBarrier b; b.bar = bar; b.x = xb_xcc_id(); b.st = st;
    if (threadIdx.x == 0) (void)xb_add(&bar[XB_XCNT(b.x)], 1u);
    return b;
}
__device__ __forceinline__ void xcd_barrier_complete(unsigned* bar, unsigned x, unsigned& nloc, unsigned& nx) {
    const unsigned G = gridDim.x * gridDim.y * gridDim.z;
    unsigned sum, cnt, mine, sp = 0u;
    for (;;) {
        sum = 0u; cnt = 0u; mine = 0u;
#pragma unroll
        for (unsigned j = 0; j < 16; ++j) { const unsigned c = xb_ld(&bar[XB_XCNT(j)]); sum += c; cnt += (c > 0u) ? 1u : 0u; mine = (j == x) ? c : mine; }
        if (sum == G) break;
        __builtin_amdgcn_s_sleep(1);
        if ((++sp & 255u) == 0u) { if (xb_ld(&bar[XB_TMO])) break; if (sp > XB_SPIN_CAP) { atomicAdd(&bar[XB_TMO], 1u); break; } }
    }
    nloc = mine > 0u ? mine : 1u; nx = cnt > 0u ? cnt : 1u;
}

__device__ __forceinline__ void xcd_barrier(const XcdBarrier& b) {
    asm volatile("s_waitcnt vmcnt(0)" ::: "memory");
    __syncthreads();
    if (threadIdx.x == 0) {
        unsigned* bar = b.bar;
        __builtin_amdgcn_s_waitcnt(0);
        unsigned nloc = b.st[0], nx = b.st[1];
        if (nloc == 0u) { xcd_barrier_complete(bar, b.x, nloc, nx); b.st[0] = nloc; b.st[1] = nx; }
        const unsigned old = xb_add(&bar[XB_XSUB(b.x)], 1u);
        const unsigned gen = old / nloc;
        if (old + 1u == (gen + 1u) * nloc) {
            __builtin_amdgcn_fence(__ATOMIC_RELEASE, "agent");
            asm volatile("s_waitcnt vmcnt(0)" ::: "memory");
            const unsigned og = xb_add(&bar[XB_TOP], 1u);
            const unsigned tg = og / nx;
            if (og + 1u == (tg + 1u) * nx) xb_add(&bar[XB_TOPGEN], 1u);
            else XB_SPIN(xb_ld(&bar[XB_TOPGEN]) == tg, bar);
            __builtin_amdgcn_fence(__ATOMIC_ACQUIRE, "agent");
            xb_add(&bar[XB_XGEN(b.x)], 1u);
            asm volatile("s_waitcnt vmcnt(0)" ::: "memory");
        } else {
            XB_SPIN(xb_ld(&bar[XB_XGEN(b.x)]) == gen, bar);
            __builtin_amdgcn_fence(__ATOMIC_ACQUIRE, "agent");
            asm volatile("s_waitcnt vmcnt(0)" ::: "memory");
        }
    }
    __syncthreads();
}

__constant__ unsigned char kPhaseKind[NPH] = {0, 1, 10, 20, 4, 2, 5, 6, 3, 11, 21, 30, 4, 2, 5, 6, 3, 8, 12, 22, 9, 31, 4, 2, 5, 6, 3, 13, 23, 32, 4, 2, 5, 6, 3};
#ifndef REP_A
#define REP_A 1
#endif
#ifndef REP_B
#define REP_B 1
#endif
#ifndef REP_C
#define REP_C 1
#endif
#ifndef REP_D
#define REP_D 1
#endif
#ifndef REP_E
#define REP_E 1
#endif
#ifndef REP_F
#define REP_F 1
#endif
__constant__ unsigned char kPhaseRep[NPH] = {REP_E, 1, REP_C, REP_A, 1, 1, REP_B, REP_B, 1, REP_C, REP_F, 1, 1, 1, REP_B, REP_B, 1, 1, REP_C, REP_D, 1, 1, 1, 1, REP_B, REP_B, 1, REP_C, 1, 1, 1, 1, REP_B, REP_B, 1};
__constant__ unsigned char kPhaseLayer[NPH] = {0, 0, 0, 0, 0, 0, 0, 0, 0, 1, 1, 1, 1, 1, 1, 1, 1, 2, 2, 2, 2, 2, 2, 2, 2, 2, 2, 3, 3, 3, 3, 3, 3, 3, 3};
__global__ void __launch_bounds__(512, 2) mega_fwd(P kp) {
    extern __shared__ __attribute__((aligned(16))) unsigned char lds_raw[];
    cg::grid_group grid = cg::this_grid();
    LAS unsigned char* lds = (LAS unsigned char*)lds_raw;
    volatile LAS unsigned* bst = (volatile LAS unsigned*)(lds + LDS_BYTES - 64);
    if (threadIdx.x == 0) { bst[0] = 0u; bst[1] = 0u; }
    __syncthreads();
    const XcdBarrier xbar = xcd_barrier_post((unsigned*)(kp.ws + WS_CTL), bst);
    int rep = 0, nsync = 0;
    for (int ph = kp.ph_lo; ph < kp.ph_hi;) {
        int z = 0; asm volatile("" : "+s"(z));
        const PZ p{kp, z};
        bf16_t* Wb = (bf16_t*)(p.ws() + WS_W);
        bf16_t* HA = (bf16_t*)(p.ws() + WS_HA);
        bf16_t* Yb = (bf16_t*)(p.ws() + WS_Y);
        bf16_t* BIG = (bf16_t*)(p.ws() + WS_BIG);
        bool sync_after = true;
        int tid = threadIdx.x; asm volatile("" : "+v"(tid));
        const int lane = tid & 63, wave = __builtin_amdgcn_readfirstlane(tid >> 6);
        const int kind = kPhaseKind[ph], layer = kPhaseLayer[ph];
#ifndef PHASE_MASK
#define PHASE_MASK 0xFFFFFFFFFFFFull
#endif
#define PM(k) (((PHASE_MASK) >> (k)) & 1ull)
        switch (kind) {
        case 0: if (PM(0)) prep_phase(p, lds, tid, wave, lane); break;
        case 1: if (PM(1)) row_phase(p, layer, 0, wave, lane); break;
        case 2: if (PM(2)) row_phase(p, layer, 1, wave, lane); break;
        case 3: if (PM(3)) row_phase(p, layer, 2, wave, lane); break;
        case 4: if (PM(4)) {
            const size_t wo = layer == 0 ? W_A_WO : layer == 1 ? W_G_WO : layer == 2 ? W_R_WO : W_H_WO;
            EpiP<FPlain> E{{Yb, 1024}}; if (layer == 3) run_gemm_lat(lds, HA, Wb + wo, 1024, 1024, E, tid); else run_gemm(lds, HA, Wb + wo, 1024, 1024, E, tid); } break;
        case 5: if (PM(5)) { EpiP<FRelu2> E{{BIG, 4096}}; if (layer == 3) run_gemm_lat(lds, HA, Wb + W_MLP_IN + (size_t)layer * 4194304, 4096, 1024, E, tid); else run_gemm(lds, HA, Wb + W_MLP_IN + (size_t)layer * 4194304, 4096, 1024, E, tid); } break;
        case 6: if (PM(6)) { EpiP<FPlain> E{{HA, 1024}};     if (layer == 3) run_gemm_lat(lds, BIG, Wb + W_MLP_OUT + (size_t)layer * 4194304, 1024, 4096, E, tid); else { run_gemm(lds, BIG, Wb + W_MLP_OUT + (size_t)layer * 4194304, 1024, 4096, E, tid); prep_filler(p, lds, tid, wave, lane, layer + 1); } } break;
        case 8: if (PM(8)) dx_phase(p, wave, lane); break;
        case 9: if (PM(9)) {
            EpiP<FPlain> E{{BIG, 3072}}; run_gemm(lds, (const bf16_t*)(p.ws() + WS_BIG + BIG_SG), Wb + W_R_GUP, 1024, 256, E, tid); } break;
        case 10: if (PM(10)) { EpiN<FQkv> E{{BIG, (bf16_t*)(p.ws() + WS_BIG + BIG_VT), (const float*)(p.ws() + WS_SMALL)}}; run_gemm(lds, HA, Wb + W_A_QKV, 1536, 1024, E, tid); } break;
        case 11: if (PM(11)) { EpiP<FGlaIn> E{{BIG, (float*)(p.ws() + WS_T), Yb}}; run_gemm(lds, HA, Wb + W_G_WIN, 3328, 1024, E, tid); } break;
        case 12: if (PM(12)) { EpiP<FRwkvIn> E{{BIG, (bf16_t*)(p.ws() + WS_BIG + BIG_LR), (bf16_t*)(p.ws() + WS_BIG + BIG_SG)}}; run_gemm(lds, HA, Wb + W_R_B2, 3584, 2048, E, tid); } break;
        case 13: if (PM(13)) { EpiP<FHgrnIn> E{{BIG, Yb}}; run_gemm(lds, HA, Wb + W_H_WIN, 5120, 1024, E, tid); } break;
        case 20: if (PM(20)) attn_phase(p, lds, tid, wave, lane); break;
        case 21: if (PM(21)) gla_scan_phase(p, lds, tid, wave, lane); break;
        case 22: if (PM(22)) rwkv_chunk_scan_phase(p, lds, wave, lane); break;
        case 23: if (PM(23)) chunk_scan_phase<1>(p, lds, tid, wave, lane); break;
        case 30: if (PM(30)) post_diag_phase<0>(p, wave, lane); break;
        case 31: if (PM(31)) post_rwkv_phase(p, wave, lane); break;
        case 32: if (PM(32)) post_diag_phase<1>(p, wave, lane); break;
        default: break;
        }
        ++rep;
        if (rep < kPhaseRep[ph]) { xcd_barrier(xbar); continue; }
        rep = 0;
        if (ph + 1 < kp.ph_hi) {
            if (!sync_after) __syncthreads();
            else if (nsync++ == 0) grid.sync();
            else xcd_barrier(xbar);
        }
        ++ph;
    }
}

extern "C" void kernel_launch(void* const* d_in, const int* in_sizes, int n_in, void* d_out, int out_size, void* d_ws, size_t ws_size, hipStream_t stream) {
    static int grid = 0;
    if (grid == 0) {
        if (n_in != 42 || ws_size < WS_END) { fprintf(stderr, "kernel_launch: unexpected n_in %d / ws_size %zu (need %zu)\n", n_in, ws_size, (size_t)WS_END); grid = -1; return; }
        int dev = 0, cus = 0, per_cu = 0;
        hipGetDevice(&dev);
        hipDeviceGetAttribute(&cus, hipDeviceAttributeMultiprocessorCount, dev);
        if (hipFuncSetAttribute((const void*)mega_fwd, hipFuncAttributeMaxDynamicSharedMemorySize, LDS_BYTES) != hipSuccess) { fprintf(stderr, "kernel_launch: hipFuncSetAttribute failed\n"); grid = -1; return; }
        if (hipOccupancyMaxActiveBlocksPerMultiprocessor(&per_cu, (const void*)mega_fwd, 512, LDS_BYTES) != hipSuccess || per_cu < 1) { fprintf(stderr, "kernel_launch: occupancy query says %d\n", per_cu); per_cu = 1; }
        (void)hipGetLastError();
        grid = cus * 1;
    }
    if (grid < 0) return;
    if (hipMemsetAsync((char*)d_ws + WS_CTL, 0, XCD_BAR_WORDS * 4, stream) != hipSuccess) { fprintf(stderr, "kernel_launch: memset of the barrier words failed\n"); return; }
    P p{};
    for (int i = 0; i < 42; ++i) p.in[i] = (const float*)d_in[i];
    p.out = (float*)d_out; p.ws = (unsigned char*)d_ws; p.ph_lo = 0; p.ph_hi = NPH;
    void* args[] = {&p};
    hipError_t e = hipLaunchCooperativeKernel((const void*)mega_fwd, dim3(grid), dim3(512), args, LDS_BYTES, stream);
    if (e != hipSuccess) fprintf(stderr, "cooperative launch failed: %s (grid %d)\n", hipGetErrorString(e), grid);
}
```

```cpp
#include <hip/hip_runtime.h>
#include <hip/hip_cooperative_groups.h>
#include <cstdio>
#include <cstdint>
namespace cg = cooperative_groups;
namespace pg8 {
#define PG8_LAS __attribute__((address_space(3)))
typedef unsigned short bf16_t;
typedef short bf16x8 __attribute__((ext_vector_type(8)));
typedef float f32x4 __attribute__((ext_vector_type(4)));
typedef unsigned u32x4 __attribute__((ext_vector_type(4)));
constexpr int BM = 256, BK = 64, HALF = 128, HTB = HALF * BK * 2  , STAGE_BYTES = 8 * HTB, NXCD = 8, WGM = 8;

__host__ __device__ __forceinline__ int lds_byte(int r, int c) { const int st = (r >> 4) * 2 + (c >> 5), rr = r & 15, cc = c & 31, ob = rr * 64 + cc * 2; return st * 1024 + (ob ^ (((ob >> 9) & 1) << 5)); }
__host__ __device__ __forceinline__ void stage_rc(int b, int& R, int& C) { const int st = b / 1024, sb = b % 1024, swz = sb ^ (((sb >> 9) & 1) << 5); R = (st >> 1) * 16 + swz / 64; C = (st & 1) * 32 + (swz % 64) / 2; }
__host__ __device__ __forceinline__ int perm32(int rho) { const int n = rho >> 4, i = rho & 15; return 8 * (i >> 2) + 4 * n + (i & 3); }

struct Unit { int pm, pn; };
struct Gemm { const bf16_t* A; const bf16_t* Bt; int M, N, K; };

struct StaticOrder {
    int nM, nN, nwg, G, c;
    __host__ __device__ void init(int M, int N, int G_, int c_) { nM = M / BM; nN = N / BM; nwg = nM * nN; G = G_; c = c_; }
    __host__ __device__ bool next(int i, Unit& u) const {
        const long L = (long)i * G + c; if (L >= nwg) return false;
        int wgid = (int)L; { const int q = nwg / NXCD, r = nwg % NXCD, xcd = wgid % NXCD, off = wgid / NXCD; wgid = (xcd < r ? xcd * (q + 1) : r * (q + 1) + (xcd - r) * q) + off; }
        const int nig = WGM * nN, gid = wgid / nig, fm = gid * WGM, gsz = (nM - fm) < WGM ? (nM - fm) : WGM;
        u.pm = fm + ((wgid % nig) % gsz); u.pn = (wgid % nig) / gsz; return true;
    }
    __device__ __forceinline__ void a_ready(const Unit&) const {}
    __device__ __forceinline__ void done(const Unit&) const {}
};

__device__ __forceinline__ unsigned cvt_pk_bf16(float lo, float hi) { unsigned r; asm volatile("v_cvt_pk_bf16_f32 %0, %1, %2" : "=v"(r) : "v"(lo), "v"(hi)); return r; }
typedef float f32x2 __attribute__((ext_vector_type(2)));
template <class Epi, class Sched, bool ALIGN_EPI = false, bool SP2 = false>
__device__ __forceinline__ void gemm_phase(PG8_LAS unsigned char* lds, const Gemm g, const Sched& S, const Epi& E, const int tid) {
    const int wid = __builtin_amdgcn_readfirstlane(tid >> 6), lane = tid & 63, wr = wid >> 2, wc = wid & 3, fr = lane & 15, fq = lane >> 4;
    const int K = g.K, nt = K / BK;
    unsigned voffA[2], voffB[2];
#pragma unroll
    for (int i = 0; i < 2; ++i) { int R, C; stage_rc(tid * 16 + i * 8192, R, C); const int Rb = Epi::PERM ? ((R & ~31) + perm32(R & 31)) : R;
        voffA[i] = (unsigned)(R * K + C) * 2u; voffB[i] = (unsigned)(Rb * K + C) * 2u; }
    const size_t kstep = (size_t)(BK * 2);
    const size_t hstep = (size_t)HALF * K * 2;
    const size_t tstep = 2 * hstep;
    const unsigned ldsw = (unsigned)wid * 1024u;
    const int aoff = lds_byte(wr * 64 + fr, fq * 8), boff = lds_byte(wc * 32 + fr, fq * 8);
#define PG8_SA(b, h) (((b) * 2 + (h)) * HTB)
#define PG8_SB(b, h) ((4 + (b) * 2 + (h)) * HTB)
#define PG8_STAGE(bufoff, gbase, voff) do { _Pragma("unroll") for (int _i = 0; _i < 2; ++_i) \
        __builtin_amdgcn_global_load_lds((const unsigned*)((const char*)(gbase) + (voff)[_i]), (PG8_LAS unsigned*)(lds + (bufoff) + ldsw + _i * 8192), 16, 0, 0); } while (0)
#define PG8_LDA(dst, b, h) do { _Pragma("unroll") for (int m = 0; m < 4; ++m) _Pragma("unroll") for (int k = 0; k < 2; ++k) dst[m][k] = *(const PG8_LAS bf16x8*)(lds + PG8_SA(b, h) + aoff + m * 2048 + k * 1024); } while (0)
#define PG8_LDB(dst, b, h) do { _Pragma("unroll") for (int n = 0; n < 2; ++n) _Pragma("unroll") for (int k = 0; k < 2; ++k) dst[n][k] = *(const PG8_LAS bf16x8*)(lds + PG8_SB(b, h) + boff + n * 2048 + k * 1024); } while (0)
#define PG8_MMA(ai, bj, At, Bt) do { __builtin_amdgcn_s_setprio(1); _Pragma("unroll") for (int m = 0; m < 4; ++m) _Pragma("unroll") for (int n = 0; n < 2; ++n) _Pragma("unroll") for (int k = 0; k < 2; ++k) \
        acc[ai][bj][m][n] = __builtin_amdgcn_mfma_f32_16x16x32_bf16(Bt[n][k], At[m][k], acc[ai][bj][m][n], 0, 0, 0); __builtin_amdgcn_s_setprio(0); } while (0)
#define PG8_WAIT_V(n) asm volatile("s_waitcnt vmcnt(" #n ")" ::: "memory")
#define PG8_WAIT_L(n) asm volatile("s_waitcnt lgkmcnt(" #n ")" ::: "memory")
#define PG8_BAR __builtin_amdgcn_s_barrier()
#define PG8_SCHED __builtin_amdgcn_sched_barrier(0)
    Unit cur, nxt; int ui = 0;
    if (!S.next(0, cur)) return;
    f32x4 acc[2][2][4][2];
#pragma unroll
    for (int a = 0; a < 2; ++a)
#pragma unroll
        for (int b = 0; b < 2; ++b)
#pragma unroll
            for (int m = 0; m < 4; ++m)
#pragma unroll
                for (int n = 0; n < 2; ++n) acc[a][b][m][n] = (f32x4){0.f, 0.f, 0.f, 0.f};
    bf16x8 At[4][2], B0[2][2], B1[2][2];
    const char* cA = (const char*)g.A + (size_t)cur.pm * tstep; const char* cB = (const char*)g.Bt + (size_t)cur.pn * tstep;
    S.a_ready(cur);
    if constexpr (SP2) {
        PG8_STAGE(PG8_SB(0, 0), cB, voffB); PG8_STAGE(PG8_SB(0, 1), cB + hstep, voffB); PG8_STAGE(PG8_SA(0, 0), cA, voffA); PG8_STAGE(PG8_SA(0, 1), cA + hstep, voffA);
        if (wr == 1) PG8_BAR;
        PG8_WAIT_V(2); PG8_BAR;
        PG8_STAGE(PG8_SB(1, 0), cB + kstep, voffB); PG8_STAGE(PG8_SA(1, 0), cA + kstep, voffA); PG8_STAGE(PG8_SB(1, 1), cB + hstep + kstep, voffB);
        PG8_WAIT_V(6); PG8_BAR;
    } else {
        PG8_STAGE(PG8_SB(0, 0), cB, voffB); PG8_STAGE(PG8_SA(0, 0), cA, voffA); PG8_STAGE(PG8_SB(0, 1), cB + hstep, voffB); PG8_STAGE(PG8_SA(0, 1), cA + hstep, voffA);
        if (wr == 1) PG8_BAR;
        PG8_WAIT_V(4); PG8_BAR;
        PG8_STAGE(PG8_SB(1, 0), cB + kstep, voffB); PG8_STAGE(PG8_SA(1, 0), cA + kstep, voffA); PG8_STAGE(PG8_SB(1, 1), cB + hstep + kstep, voffB);
        PG8_WAIT_V(6); PG8_BAR;
    }
    for (;;) {
        const bool has_next = S.next(ui + 1, nxt);
        const char* nA = has_next ? (const char*)g.A + (size_t)nxt.pm * tstep : cA; const char* nB = has_next ? (const char*)g.Bt + (size_t)nxt.pn * tstep : cB;
        for (int t = 0; t < nt; t += 2) {
            const bool last = (t == nt - 2);
            const char* a1 = cA + (size_t)(t + 1) * kstep;
            const char* a2 = last ? nA : cA + (size_t)(t + 2) * kstep; const char* b2 = last ? nB : cB + (size_t)(t + 2) * kstep;
            const char* a3 = a2 + kstep; const char* b3 = b2 + kstep;
            if (last && has_next) S.a_ready(nxt);
            if constexpr (SP2) {
            PG8_LDB(B0, 0, 0); PG8_LDB(B1, 0, 1); PG8_SCHED; PG8_LDA(At, 0, 0); PG8_STAGE(PG8_SA(1, 1), a1 + hstep, voffA);
            PG8_WAIT_V(8); PG8_WAIT_L(0); PG8_BAR; PG8_MMA(0, 0, At, B0); PG8_MMA(0, 1, At, B1); PG8_BAR; PG8_SCHED;
            PG8_LDA(At, 0, 1); PG8_STAGE(PG8_SB(0, 0), b2, voffB); PG8_STAGE(PG8_SB(0, 1), b2 + hstep, voffB); PG8_STAGE(PG8_SA(0, 0), a2, voffA);
            PG8_WAIT_V(8); PG8_WAIT_L(0); PG8_BAR; PG8_MMA(1, 0, At, B0); PG8_MMA(1, 1, At, B1); PG8_BAR; PG8_SCHED;
            PG8_LDB(B0, 1, 0); PG8_LDB(B1, 1, 1); PG8_SCHED; PG8_LDA(At, 1, 0); PG8_STAGE(PG8_SA(0, 1), a2 + hstep, voffA);
            PG8_WAIT_V(8); PG8_WAIT_L(0); PG8_BAR; PG8_MMA(0, 0, At, B0); PG8_MMA(0, 1, At, B1); PG8_BAR; PG8_SCHED;
            PG8_LDA(At, 1, 1); PG8_STAGE(PG8_SB(1, 0), b3, voffB); PG8_STAGE(PG8_SB(1, 1), b3 + hstep, voffB); PG8_STAGE(PG8_SA(1, 0), a3, voffA);
            PG8_WAIT_V(8); PG8_WAIT_L(0); PG8_BAR; PG8_MMA(1, 0, At, B0); PG8_MMA(1, 1, At, B1); PG8_BAR; PG8_SCHED;
            } else {
            PG8_LDB(B0, 0, 0); PG8_SCHED; PG8_LDA(At, 0, 0); PG8_STAGE(PG8_SA(1, 1), a1 + hstep, voffA);
            PG8_WAIT_L(8); PG8_BAR; PG8_WAIT_L(0); PG8_MMA(0, 0, At, B0); PG8_BAR; PG8_SCHED;
            PG8_LDB(B1, 0, 1); PG8_STAGE(PG8_SB(0, 0), b2, voffB);
            PG8_BAR; PG8_WAIT_L(0); PG8_MMA(0, 1, At, B1); PG8_BAR;
            PG8_LDA(At, 0, 1); PG8_STAGE(PG8_SA(0, 0), a2, voffA);
            PG8_BAR; PG8_WAIT_L(0); PG8_MMA(1, 0, At, B0); PG8_BAR; PG8_SCHED;
            PG8_STAGE(PG8_SB(0, 1), b2 + hstep, voffB);
            PG8_WAIT_V(6); PG8_BAR; PG8_MMA(1, 1, At, B1); PG8_BAR;
            PG8_LDB(B0, 1, 0); PG8_SCHED; PG8_LDA(At, 1, 0); PG8_STAGE(PG8_SA(0, 1), a2 + hstep, voffA);
            PG8_WAIT_L(8); PG8_BAR; PG8_WAIT_L(0); PG8_MMA(0, 0, At, B0); PG8_BAR; PG8_SCHED;
            PG8_LDB(B1, 1, 1); PG8_STAGE(PG8_SB(1, 0), b3, voffB);
            PG8_BAR; PG8_WAIT_L(0); PG8_MMA(0, 1, At, B1); PG8_BAR;
            PG8_LDA(At, 1, 1); PG8_STAGE(PG8_SA(1, 0), a3, voffA);
            PG8_BAR; PG8_WAIT_L(0); PG8_MMA(1, 0, At, B0); PG8_BAR; PG8_SCHED;
            PG8_STAGE(PG8_SB(1, 1), b3 + hstep, voffB);
            PG8_WAIT_V(6); PG8_BAR; PG8_MMA(1, 1, At, B1); PG8_BAR;
            }
        }
        if constexpr (ALIGN_EPI) { if (wr == 0) PG8_BAR; }
        if constexpr (!Epi::AFTER_DRAIN) { E(acc, cur, wr, wc, fr, fq); S.done(cur); }
        if (!has_next) break;
#pragma unroll
        for (int a = 0; a < 2; ++a)
#pragma unroll
            for (int b = 0; b < 2; ++b)
#pragma unroll
                for (int m = 0; m < 4; ++m)
#pragma unroll
                    for (int n = 0; n < 2; ++n) acc[a][b][m][n] = (f32x4){0.f, 0.f, 0.f, 0.f};
        cur = nxt; cA = nA; cB = nB; ++ui;
        if constexpr (ALIGN_EPI) { if (wr == 1) PG8_BAR; }
    }
    PG8_WAIT_V(0);
    if constexpr (!ALIGN_EPI) { if (wr == 0) PG8_BAR; }
    PG8_BAR;
    if constexpr (Epi::AFTER_DRAIN) { E.fused(acc, cur, wr, wc, fr, fq, lds, wid, lane); S.done(cur); }
#undef PG8_SA
#undef PG8_SB
#undef PG8_STAGE
#undef PG8_LDA
#undef PG8_LDB
#undef PG8_MMA
#undef PG8_WAIT_V
#undef PG8_WAIT_L
#undef PG8_BAR
#undef PG8_SCHED
}
}

#define DI __device__ __forceinline__
#define LAS __attribute__((address_space(3)))
typedef unsigned short bf16_t;
typedef short bf16x8 __attribute__((ext_vector_type(8)));
typedef float f32x4 __attribute__((ext_vector_type(4)));
typedef float f32x2 __attribute__((ext_vector_type(2)));
typedef unsigned u32x4 __attribute__((ext_vector_type(4)));
typedef unsigned u32x2 __attribute__((ext_vector_type(2)));

constexpr int DM = 1024, NBATCH = 32, NLAT = 2048, NCTX = 256, TT = 2304, MTOK = NBATCH * TT, HID = 4096;
constexpr int NPH = 35;
constexpr int LDS_BYTES = 147456;
constexpr size_t MiB = 1u << 20;
constexpr size_t WS_W = 0;
constexpr size_t WS_MOD = 108 * MiB;
constexpr size_t WS_SMALL = 112 * MiB;
constexpr size_t WS_XC = 113 * MiB;
constexpr size_t WS_HA = 145 * MiB;
constexpr size_t WS_Y = 289 * MiB;
constexpr size_t WS_BIG = 433 * MiB;
constexpr size_t WS_T = 1009 * MiB;
constexpr size_t WS_CTL = 1018 * MiB;
constexpr size_t WS_END = 1019 * MiB;
constexpr size_t W_MLP_IN = 0, W_MLP_OUT = 4 * 4194304ull;
constexpr size_t W_A_QKV = 8 * 4194304ull, W_A_WO = W_A_QKV + 1572864;
constexpr size_t W_G_WIN = W_A_WO + 1048576, W_G_WOG = W_G_WIN + 2359296, W_G_WO = W_G_WOG + 1048576;
constexpr size_t W_R_B2 = W_G_WO + 1048576, W_R_GUP = W_R_B2 + 7340032, W_R_WO = W_R_GUP + 262144;
constexpr size_t W_H_WIN = W_R_WO + 1048576, W_H_WOG = W_H_WIN + 4194304, W_H_WO = W_H_WOG + 1048576;
constexpr size_t W_TOTAL = W_H_WO + 1048576;
static_assert(W_TOTAL * 2 <= WS_MOD, "weights fit");
constexpr size_t BIG_VT = 216 * MiB;
constexpr size_t BIG_LR = 432 * MiB, BIG_SG = 468 * MiB, BIG_BS = 504 * MiB;

struct P {
    const float* in[42];
    float* out;
    unsigned char* ws;
    int ph_lo, ph_hi;
};

typedef __bf16 bf16x2_t __attribute__((ext_vector_type(2)));
DI unsigned cvtpk(float lo, float hi) { const f32x2 v = (f32x2){lo, hi}; const bf16x2_t b = __builtin_convertvector(v, bf16x2_t); return __builtin_bit_cast(unsigned, b); }
DI unsigned short f2bf(float f) { return (unsigned short)(cvtpk(f, f) & 0xffffu); }
DI float bf2f(unsigned short u) { return __uint_as_float((unsigned)u << 16); }
DI unsigned pk2(float lo, float hi) { return (unsigned)f2bf(lo) | ((unsigned)f2bf(hi) << 16); }
DI float sigmoid_f(float x) { return __builtin_amdgcn_rcpf(1.f + __expf(-x)); }
DI float silu_f(float x) { return x * __builtin_amdgcn_rcpf(1.f + __expf(-x)); }
DI float wave_sum(float v) {
#pragma unroll
    for (int o = 1; o < 64; o <<= 1) v += __shfl_xor(v, o);
    return v;
}
#define DPPF(v, ctrl) __int_as_float(__builtin_amdgcn_mov_dpp(__float_as_int(v), (ctrl), 0xF, 0xF, true))
DI float red16(float v) { v += DPPF(v, 0xB1); v += DPPF(v, 0x4E); v += DPPF(v, 0x141); v += DPPF(v, 0x140); return v; }
DI float max16(float v) { v = fmaxf(v, __shfl_xor(v, 1)); v = fmaxf(v, __shfl_xor(v, 2)); v = fmaxf(v, __shfl_xor(v, 4)); v = fmaxf(v, __shfl_xor(v, 8)); return v; }
DI f32x4 bf4_to_f4(u32x2 w) { return (f32x4){__uint_as_float(w.x << 16), __uint_as_float(w.x & 0xffff0000u), __uint_as_float(w.y << 16), __uint_as_float(w.y & 0xffff0000u)}; }
DI u32x2 f4_to_bf4(f32x4 v) { return (u32x2){pk2(v.x, v.y), pk2(v.z, v.w)}; }
#define LDS_WAIT() asm volatile("s_waitcnt lgkmcnt(0)" ::: "memory")
DI int tok_of(int dir, int s) { return dir == 0 ? s : (s < NCTX ? (NCTX - 1 - s) : (TT + NCTX - 1 - s)); }

struct PZ {
    const P& k; int z;
    DI const float* in(int i) const { return k.in[i + z]; }
    DI unsigned char* ws() const { return k.ws + z; }
    DI float* out() const { return k.out + z; }
};
DI void tr_job(const float* W, int ldsrc, int col0, int K, int ncols, bf16_t* WT, int ld_dst, int row_off, int col_off, const float* scale,
               LAS float* scr, int gw, int NGW, int lane) {
    const int nblk = ncols / 32, nitems = (K / 64) * nblk;
    for (int item = gw; item < nitems; item += NGW) {
        const int kb = item / nblk, nb = item % nblk, k0 = 64 * kb, n0 = 32 * nb;
#pragma unroll 8
        for (int i = 0; i < 32; ++i) {
            const int kk = 2 * i + (lane >> 5);
            float v = W[(size_t)(k0 + kk) * ldsrc + col0 + n0 + (lane & 31)];
            if (scale) v *= scale[k0 + kk];
            scr[kk * 33 + (lane & 31)] = v;
        }
        LDS_WAIT();
        const int c = lane & 7;
#pragma unroll
        for (int j = 0; j < 4; ++j) {
            const int n = (lane >> 3) + 8 * j; const LAS float* s = scr + (8 * c) * 33 + n;
            u32x4 o; o.x = pk2(s[0 * 33], s[1 * 33]); o.y = pk2(s[2 * 33], s[3 * 33]); o.z = pk2(s[4 * 33], s[5 * 33]); o.w = pk2(s[6 * 33], s[7 * 33]);
            *(u32x4*)(WT + (size_t)(row_off + n0 + n) * ld_dst + col_off + k0 + 8 * c) = o;
        }
        LDS_WAIT();
    }
}
DI void zero_rows(bf16_t* p, size_t nel, int gt, int NGT) {
    for (size_t i = (size_t)gt * 8; i < nel; i += (size_t)NGT * 8) *(u32x4*)(p + i) = (u32x4){0u, 0u, 0u, 0u};
}

DI void prep_weights(const PZ& p, LAS unsigned char* lds, int wave, int lane, int layer, int gw, int NGW, int gt, int NGT) {
    bf16_t* Wb = (bf16_t*)(p.ws() + WS_W);
    LAS float* scr = (LAS float*)(lds + wave * 16384);
    tr_job(p.in(10) + (size_t)layer * 1024 * 4096, 4096, 0, 1024, 4096, Wb + W_MLP_IN + (size_t)layer * 4194304, 1024, 0, 0, nullptr, scr, gw, NGW, lane);
    tr_job(p.in(11) + (size_t)layer * 4096 * 1024, 1024, 0, 4096, 1024, Wb + W_MLP_OUT + (size_t)layer * 4194304, 4096, 0, 0, nullptr, scr, gw, NGW, lane);
    if (layer == 0) {
        tr_job(p.in(12), 1536, 0, 1024, 1536, Wb + W_A_QKV, 1024, 0, 0, nullptr, scr, gw, NGW, lane);
        tr_job(p.in(13), 1024, 0, 1024, 1024, Wb + W_A_WO, 1024, 0, 0, nullptr, scr, gw, NGW, lane);
    } else if (layer == 1) {
        tr_job(p.in(15), 3072, 0, 1024, 2048, Wb + W_G_WIN, 1024, 0, 0, nullptr, scr, gw, NGW, lane);
        tr_job(p.in(15), 3072, 2048, 1024, 1024, Wb + W_G_WOG, 1024, 0, 0, nullptr, scr, gw, NGW, lane);
        tr_job(p.in(20), 1024, 0, 1024, 1024, Wb + W_G_WO, 1024, 0, 0, nullptr, scr, gw, NGW, lane);
        for (int i = gt; i < 32 * 1024; i += NGT) { const int n = i >> 10, k = i & 1023; Wb[W_G_WIN + (size_t)(2048 + n) * 1024 + k] = f2bf(p.in(16)[((size_t)(n >> 4) * 1024 + k) * 16 + (n & 15)]); }
        zero_rows(Wb + W_G_WIN + (size_t)2080 * 1024, (size_t)224 * 1024, gt, NGT);
    } else if (layer == 2) {
        for (int j = 0; j < 3; ++j) {
            tr_job(p.in(22) + (size_t)j * 1048576, 1024, 0, 1024, 1024, Wb + W_R_B2, 2048, j * 1024, 0, nullptr, scr, gw, NGW, lane);
            tr_job(p.in(22) + (size_t)j * 1048576, 1024, 0, 1024, 1024, Wb + W_R_B2, 2048, j * 1024, 1024, p.in(21) + j * 1024, scr, gw, NGW, lane);
        }
        for (int d = 0; d < 2; ++d) {
            tr_job(p.in(24) + (size_t)d * 65536, 64, 0, 1024, 64, Wb + W_R_B2, 2048, 3072 + d * 64, 0, nullptr, scr, gw, NGW, lane);
            tr_job(p.in(24) + (size_t)d * 65536, 64, 0, 1024, 64, Wb + W_R_B2, 2048, 3072 + d * 64, 1024, p.in(21) + 3 * 1024, scr, gw, NGW, lane);
            tr_job(p.in(27) + (size_t)d * 65536, 64, 0, 1024, 64, Wb + W_R_B2, 2048, 3200 + d * 64, 0, nullptr, scr, gw, NGW, lane);
            tr_job(p.in(27) + (size_t)d * 65536, 64, 0, 1024, 64, Wb + W_R_B2, 2048, 3200 + d * 64, 1024, p.in(21) + 4 * 1024, scr, gw, NGW, lane);
        }
        tr_job(p.in(29), 128, 0, 1024, 128, Wb + W_R_B2, 2048, 3328, 0, nullptr, scr, gw, NGW, lane);
        tr_job(p.in(29), 128, 0, 1024, 128, Wb + W_R_B2, 2048, 3328, 1024, p.in(21) + 5 * 1024, scr, gw, NGW, lane);
        zero_rows(Wb + W_R_B2 + (size_t)3456 * 2048, (size_t)128 * 2048, gt, NGT);
        tr_job(p.in(30), 1024, 0, 128, 1024, Wb + W_R_GUP, 256, 0, 0, nullptr, scr, gw, NGW, lane);
        for (int i = gt; i < 1024 * 16; i += NGT) { const int n = i >> 4, c = i & 15; *(u32x4*)(Wb + W_R_GUP + (size_t)n * 256 + 128 + c * 8) = (u32x4){0u, 0u, 0u, 0u}; }
        tr_job(p.in(36), 1024, 0, 1024, 1024, Wb + W_R_WO, 1024, 0, 0, nullptr, scr, gw, NGW, lane);
        for (int d = 0; d < 2; ++d) {
            tr_job(p.in(25) + (size_t)d * 65536, 1024, 0, 64, 1024, (bf16_t*)(p.ws() + WS_SMALL + 65536) + (size_t)d * 65536, 64, 0, 0, nullptr, scr, gw, NGW, lane);
            tr_job(p.in(28) + (size_t)d * 65536, 1024, 0, 64, 1024, (bf16_t*)(p.ws() + WS_SMALL + 65536) + (size_t)(2 + d) * 65536, 64, 0, 0, nullptr, scr, gw, NGW, lane);
        }
    } else {
        tr_job(p.in(37), 3072, 0, 1024, 1024, Wb + W_H_WIN, 1024, 0, 0, nullptr, scr, gw, NGW, lane);
        tr_job(p.in(38), 1024, 0, 1024, 1024, Wb + W_H_WIN, 1024, 1024, 0, nullptr, scr, gw, NGW, lane);
        tr_job(p.in(38) + 1048576, 1024, 0, 1024, 1024, Wb + W_H_WIN, 1024, 2048, 0, nullptr, scr, gw, NGW, lane);
        tr_job(p.in(37), 3072, 1024, 1024, 1024, Wb + W_H_WIN, 1024, 3072, 0, nullptr, scr, gw, NGW, lane);
        tr_job(p.in(37), 3072, 2048, 1024, 1024, Wb + W_H_WOG, 1024, 0, 0, nullptr, scr, gw, NGW, lane);
        tr_job(p.in(41), 1024, 0, 1024, 1024, Wb + W_H_WO, 1024, 0, 0, nullptr, scr, gw, NGW, lane);
    }
}
DI void prep_filler(const PZ& p, LAS unsigned char* lds, int tid, int wave, int lane, int layer) {
    int nb = gridDim.x; asm volatile("" : "+s"(nb));
    const int busy = (288 * 4) % nb;
    const int c = (int)blockIdx.x;
    if (c < busy) return;
    prep_weights(p, lds, wave, lane, layer, (c - busy) * 8 + wave, (nb - busy) * 8, (c - busy) * 512 + tid, (nb - busy) * 512);
}
DI void prep_phase(const PZ& p, LAS unsigned char* lds, int tid, int wave, int lane) {
    int nb = gridDim.x; asm volatile("" : "+s"(nb));
    const int gw = blockIdx.x * 8 + wave, NGW = nb * 8, gt = blockIdx.x * 512 + tid, NGT = nb * 512;
    prep_weights(p, lds, wave, lane, 0, gw, NGW, gt, NGT);
    float* small = (float*)(p.ws() + WS_SMALL);
    if (blockIdx.x == 0) {
        for (int i = tid; i < 1024; i += 512) {
            const int pp = i >> 4, f = i & 15;
            const float inv = exp2f(-(float)f * 0.8304820237218406f);
            const float ang = (float)pp * inv;
            small[2 * i] = __cosf(ang); small[2 * i + 1] = __sinf(ang);
        }
    }
    if (blockIdx.x == 1 % nb) {
        for (int i = tid; i < 1024; i += 512) {
            const float a0 = p.in(39)[i], a1 = p.in(39)[1024 + i], a2 = p.in(39)[2048 + i], a3 = p.in(39)[3072 + i];
            const float mx = fmaxf(fmaxf(a0, a1), fmaxf(a2, a3));
            const float e0 = expf(a0 - mx), e1 = expf(a1 - mx), e2 = expf(a2 - mx), e3 = expf(a3 - mx);
            small[2048 + i] = (e1 + e2 + e3) / (e0 + e1 + e2 + e3);
        }
    }
    __syncthreads();
    LAS float* sc = (LAS float*)lds;
    LAS float* red = sc + 1024 * 33;
    for (int i = tid; i < 33 * 1024; i += 512) { const int r = i >> 10, k = i & 1023; const float cv = r < 32 ? p.in(1)[r * 1024 + k] : p.in(3)[k]; sc[k * 33 + r] = silu_f(cv); }
    __syncthreads();
    float* MOD = (float*)(p.ws() + WS_MOD);
    for (int grp = blockIdx.x; grp < 4 * 96; grp += nb) {
        const int l = grp / 96, n = (grp % 96) * 64 + lane;
        float acc[33];
#pragma unroll
        for (int r = 0; r < 33; ++r) acc[r] = 0.f;
        const float* wp = p.in(4) + ((size_t)l * 1024 + wave * 128) * 6144 + n;
        for (int kb = 0; kb < 128; kb += 8) {
            float wv[8];
#pragma unroll
            for (int i = 0; i < 8; ++i) wv[i] = wp[(size_t)(kb + i) * 6144];
#pragma unroll
            for (int i = 0; i < 8; ++i) {
                const LAS float* s = sc + (wave * 128 + kb + i) * 33;
#pragma unroll
                for (int r = 0; r < 33; ++r) acc[r] += wv[i] * s[r];
            }
        }
#pragma unroll
        for (int r = 0; r < 33; ++r) {
            red[wave * 64 + lane] = acc[r];
            __syncthreads();
            if (wave == 0) {
                float s = 0.f;
#pragma unroll
                for (int w = 0; w < 8; ++w) s += red[w * 64 + lane];
                MOD[((size_t)l * 33 + r) * 6144 + n] = s + p.in(5)[l * 6144 + n];
            }
            __syncthreads();
        }
    }
}

DI void row_phase(const PZ& p, int layer, int mode, int wave, int lane) {
    const int gw = blockIdx.x * 8 + wave, NGW = gridDim.x * 8;
    const bool from_in = (layer == 0);
    const float* xl_src = from_in ? p.in(0) : p.out();
    const float* xc_src = from_in ? p.in(2) : (const float*)(p.ws() + WS_XC);
    float* xc_dst = (float*)(p.ws() + WS_XC);
    const float* MOD = (const float*)(p.ws() + WS_MOD);
    const float* modl = MOD + (size_t)layer * 33 * 6144;
    const float* gpm = p.in(7) + layer * 1024;
    const float* gpl = p.in(9) + layer * 1024;
    const int hl = mode == 2 ? layer + 1 : layer;
    const bool do_h = hl < 4;
    const float* gpre = (mode == 1 ? p.in(8) : p.in(6)) + (do_h ? hl : 0) * 1024;
    const float* modh = MOD + (size_t)(do_h ? hl : 0) * 33 * 6144;
    const int shift_i = mode == 1 ? 3 : 0, scale_i = mode == 1 ? 4 : 1;
    bf16_t* HAo = (bf16_t*)(p.ws() + ((hl == 2 && mode != 1) ? WS_BIG : WS_HA));
    const bf16_t* Y = (const bf16_t*)(p.ws() + WS_Y);
    const bf16_t* F = (const bf16_t*)(p.ws() + WS_HA);
    for (int m = gw; m < MTOK; m += NGW) {
        const int b = m / TT, t = m - b * TT; const bool isc = t < NCTX; const int mr = isc ? 32 : b;
        if (isc && layer == 3 && mode != 0) continue;
        const size_t xoff = isc ? (size_t)(b * NCTX + t) * 1024 : (size_t)(b * NLAT + t - NCTX) * 1024;
        const float* xs = (isc ? xc_src : xl_src) + xoff;
        float* xd = (isc ? xc_dst : p.out()) + xoff;
        f32x4 xv[4];
#pragma unroll
        for (int j = 0; j < 4; ++j) xv[j] = __builtin_nontemporal_load((const f32x4*)xs + lane + 64 * j);
        if (mode != 0) {
            f32x4 yv[4]; float ss = 0.f;
#pragma unroll
            for (int j = 0; j < 4; ++j) { yv[j] = bf4_to_f4(__builtin_nontemporal_load((const u32x2*)(Y + (size_t)m * 1024) + lane + 64 * j)); ss += yv[j].x * yv[j].x + yv[j].y * yv[j].y + yv[j].z * yv[j].z + yv[j].w * yv[j].w; }
            const float rstd = rsqrtf(wave_sum(ss) * (1.f / 1024.f) + 1e-6f);
#pragma unroll
            for (int j = 0; j < 4; ++j) {
                const f32x4 gate = *((const f32x4*)(modl + (size_t)mr * 6144 + 2 * 1024) + lane + 64 * j);
                const f32x4 gp = *((const f32x4*)gpm + lane + 64 * j);
                xv[j] += gate * (yv[j] * rstd * gp);
            }
        }
        if (mode == 2) {
            f32x4 yv[4]; float ss = 0.f;
#pragma unroll
            for (int j = 0; j < 4; ++j) { yv[j] = bf4_to_f4(__builtin_nontemporal_load((const u32x2*)(F + (size_t)m * 1024) + lane + 64 * j)); ss += yv[j].x * yv[j].x + yv[j].y * yv[j].y + yv[j].z * yv[j].z + yv[j].w * yv[j].w; }
            const float rstd = rsqrtf(wave_sum(ss) * (1.f / 1024.f) + 1e-6f);
#pragma unroll
            for (int j = 0; j < 4; ++j) {
                const f32x4 gate = *((const f32x4*)(modl + (size_t)mr * 6144 + 5 * 1024) + lane + 64 * j);
                const f32x4 gp = *((const f32x4*)gpl + lane + 64 * j);
                xv[j] += gate * (yv[j] * rstd * gp);
                *((f32x4*)xd + lane + 64 * j) = xv[j];
            }
        }
        if (do_h) {
            float ss = 0.f;
#pragma unroll
            for (int j = 0; j < 4; ++j) ss += xv[j].x * xv[j].x + xv[j].y * xv[j].y + xv[j].z * xv[j].z + xv[j].w * xv[j].w;
            const float rstd = rsqrtf(wave_sum(ss) * (1.f / 1024.f) + 1e-6f);
#pragma unroll
            for (int j = 0; j < 4; ++j) {
                const f32x4 g = *((const f32x4*)gpre + lane + 64 * j);
                const f32x4 sh = *((const f32x4*)(modh + (size_t)mr * 6144 + shift_i * 1024) + lane + 64 * j);
                const f32x4 sc = *((const f32x4*)(modh + (size_t)mr * 6144 + scale_i * 1024) + lane + 64 * j);
                const f32x4 h = xv[j] * rstd * g * (sc + 1.f) + sh;
                *((u32x2*)(HAo + (size_t)m * 1024) + lane + 64 * j) = f4_to_bf4(h);
            }
        }
    }
}
DI void dx_phase(const PZ& p, int wave, int lane) {
    const int gw = blockIdx.x * 8 + wave, NGW = gridDim.x * 8;
    const bf16_t* HT = (const bf16_t*)(p.ws() + WS_BIG);
    bf16_t* HA = (bf16_t*)(p.ws() + WS_HA);
    for (int m = gw; m < MTOK; m += NGW) {
        const int t = m % TT; const bool first = (t == 0 || t == NCTX), last = (t == NCTX - 1 || t == TT - 1);
        const u32x2* hp = (const u32x2*)(HT + (size_t)m * 1024) + lane;
#pragma unroll
        for (int j = 0; j < 4; ++j) {
            const u32x2 hraw = hp[64 * j];
            const f32x4 h = bf4_to_f4(hraw);
            f32x4 pv = (f32x4){0.f, 0.f, 0.f, 0.f}, nv = pv;
            if (!first) pv = bf4_to_f4((hp - 256)[64 * j]);
            if (!last) nv = bf4_to_f4((hp + 256)[64 * j]);
            const f32x4 dx = (pv + nv) * 0.5f - h;
            *((u32x2*)(HA + (size_t)m * 2048) + lane + 64 * j) = hraw;
            *((u32x2*)(HA + (size_t)m * 2048 + 1024) + lane + 64 * j) = f4_to_bf4(dx);
        }
    }
}

DI void st8(bf16_t* ptr, f32x4 v0, f32x4 v1) {
    u32x4 w; w.x = cvtpk(v0.x, v0.y); w.y = cvtpk(v0.z, v0.w); w.z = cvtpk(v1.x, v1.y); w.w = cvtpk(v1.z, v1.w);
    *(u32x4*)ptr = w;
}
template <class F> struct EpiP {
    static constexpr bool PERM = true, AFTER_DRAIN = false; F f;
    DI void operator()(const f32x4 (&acc)[2][2][4][2], const pg8::Unit& u, int wr, int wc, int fr, int fq) const {
        const int row0 = u.pm * 256 + wr * 64 + fr, col0 = u.pn * 256 + wc * 32 + 8 * fq;
#pragma unroll
        for (int ai = 0; ai < 2; ++ai)
#pragma unroll
            for (int m = 0; m < 4; ++m)
#pragma unroll
                for (int bj = 0; bj < 2; ++bj) f(row0 + ai * 128 + m * 16, col0 + bj * 128, acc[ai][bj][m][0], acc[ai][bj][m][1]);
    }
};
template <class F> struct EpiN {
    static constexpr bool PERM = false, AFTER_DRAIN = false; F f;
    DI void operator()(const f32x4 (&acc)[2][2][4][2], const pg8::Unit& u, int wr, int wc, int fr, int fq) const {
        const int row0 = u.pm * 256 + wr * 64 + fr, col0 = u.pn * 256 + wc * 32 + 4 * fq;
#pragma unroll
        for (int ai = 0; ai < 2; ++ai)
#pragma unroll
            for (int m = 0; m < 4; ++m)
#pragma unroll
                for (int bj = 0; bj < 2; ++bj) f(row0 + ai * 128 + m * 16, col0 + bj * 128, acc[ai][bj][m][0], acc[ai][bj][m][1]);
    }
};
struct FPlain { bf16_t* O; int ld; DI void operator()(int row, int col, f32x4 v0, f32x4 v1) const { st8(O + (size_t)row * ld + col, v0, v1); } };
struct FRelu2 { bf16_t* O; int ld; DI void operator()(int row, int col, f32x4 v0, f32x4 v1) const {
    v0 = __builtin_elementwise_max(v0, (f32x4){0.f, 0.f, 0.f, 0.f}); v1 = __builtin_elementwise_max(v1, (f32x4){0.f, 0.f, 0.f, 0.f});
    const f32x4 a0 = v0 * v0, a1 = v1 * v1;
    u32x4 w; w.x = cvtpk(a0.x, a0.y); w.y = cvtpk(a0.z, a0.w); w.z = cvtpk(a1.x, a1.y); w.w = cvtpk(a1.z, a1.w);
    __builtin_nontemporal_store(w, (u32x4*)(O + (size_t)row * ld + col)); } };
struct FGlaIn { bf16_t* big; float* T; bf16_t* og; DI void operator()(int row, int col, f32x4 v0, f32x4 v1) const {
    if (col >= 2304) {
#pragma unroll
        for (int i = 0; i < 4; ++i) { v0[i] = silu_f(v0[i]); v1[i] = silu_f(v1[i]); }
        st8(og + (size_t)row * 1024 + (col - 2304), v0, v1); return; }
    if (col < 2048) st8(big + (size_t)row * 4096 + col, v0, v1);
    else { const int c2 = col - 2048; if (c2 < 32) { *(f32x4*)(T + (size_t)row * 32 + c2) = v0; *(f32x4*)(T + (size_t)row * 32 + c2 + 4) = v1; } } } };
struct FHgrnIn { bf16_t* big; bf16_t* og; DI void operator()(int row, int col, f32x4 v0, f32x4 v1) const {
    if (col < 1024 || col >= 4096) {
#pragma unroll
        for (int i = 0; i < 4; ++i) { v0[i] = silu_f(v0[i]); v1[i] = silu_f(v1[i]); } }
    if (col >= 4096) st8(og + (size_t)row * 1024 + (col - 4096), v0, v1);
    else st8(big + (size_t)row * 4096 + col, v0, v1); } };
struct FRwkvIn { bf16_t* rkv; bf16_t* lr; bf16_t* sg; DI void operator()(int row, int col, f32x4 v0, f32x4 v1) const {
    if (col < 3072) { st8(rkv + (size_t)row * 3072 + col, v0, v1); }
    else if (col < 3328) { const int c2 = col - 3072;
        if (c2 < 128) {
#pragma unroll
            for (int i = 0; i < 4; ++i) { v0[i] = tanhf(v0[i]); v1[i] = tanhf(v1[i]); } }
        st8(lr + (size_t)row * 256 + c2, v0, v1); }
    else { const int c2 = col - 3328;
        if (c2 < 128) {
#pragma unroll
            for (int i = 0; i < 4; ++i) { v0[i] = sigmoid_f(v0[i]); v1[i] = sigmoid_f(v1[i]); } }
        else { v0 = (f32x4){0.f, 0.f, 0.f, 0.f}; v1 = v0; }
        st8(sg + (size_t)row * 256 + c2, v0, v1); } } };
struct FQkv { bf16_t* qkv; bf16_t* vt; const float* rope; DI void operator()(int row, int col, f32x4 a, f32x4 b) const {
    const int bb = row / TT, t = row - bb * TT;
    if (col < 1280) {
        if (t >= NCTX) {
            const int pos = t - NCTX, axis = (col >> 5) & 1, pp = axis ? (pos & 63) : (pos >> 6), f0 = col & 15;
#pragma unroll
            for (int j = 0; j < 4; ++j) {
                const float c = rope[2 * (pp * 16 + f0 + j)], s = rope[2 * (pp * 16 + f0 + j) + 1];
                const float x1 = a[j], x2 = b[j];
                a[j] = x1 * c - x2 * s; b[j] = x2 * c + x1 * s;
            }
        }
        if (col < 1024) { a = a * 0.18033688011112042f; b = b * 0.18033688011112042f; }
        bf16_t* o = qkv + (size_t)row * 1536 + col;
        *(u32x2*)o = (u32x2){cvtpk(a.x, a.y), cvtpk(a.z, a.w)};
        *(u32x2*)(o + 16) = (u32x2){cvtpk(b.x, b.y), cvtpk(b.z, b.w)};
    } else {
        const int d0 = col - 1280, kvh = d0 >> 6, d = d0 & 63;
        bf16_t* o = vt + ((size_t)(bb * 4 + kvh) * 64 + d) * TT + t;
#pragma unroll
        for (int j = 0; j < 4; ++j) { o[(size_t)j * TT] = f2bf(a[j]); o[(size_t)(16 + j) * TT] = f2bf(b[j]); }
    } } };

struct LatOrder {
    pg8::StaticOrder S;
    DI void init(int N, int G, int c) { S.init(NBATCH * NLAT, N, G, c); }
    DI bool next(int i, pg8::Unit& u) const { if (!S.next(i, u)) return false; u.pm = (u.pm >> 3) * 9 + 1 + (u.pm & 7); return true; }
    DI void a_ready(const pg8::Unit&) const {}
    DI void done(const pg8::Unit&) const {}
};
template <class Epi> DI void run_gemm_lat(LAS unsigned char* lds, const bf16_t* A, const bf16_t* Bt, int N, int K, const Epi& E, int tid) {
    pg8::Gemm g{A, Bt, MTOK, N, K}; LatOrder S; S.init(N, (int)gridDim.x, (int)blockIdx.x);
    pg8::gemm_phase<Epi, LatOrder, true, true>(lds, g, S, E, tid);
}
template <class Epi> DI void run_gemm(LAS unsigned char* lds, const bf16_t* A, const bf16_t* Bt, int N, int K, const Epi& E, int tid) {
    pg8::Gemm g{A, Bt, MTOK, N, K}; pg8::StaticOrder S; S.init(MTOK, N, (int)gridDim.x, (int)blockIdx.x);
    pg8::gemm_phase<Epi, pg8::StaticOrder, true, true>(lds, g, S, E, tid);
}

#define MFMA16(a, b, c) __builtin_amdgcn_mfma_f32_16x16x32_bf16((a), (b), (c), 0, 0, 0)
DI bf16x8 mk8(u32x2 lo, u32x2 hi) { return __builtin_bit_cast(bf16x8, ((u32x4){lo.x, lo.y, hi.x, hi.y})); }
DI void attn_phase(const PZ& p, LAS unsigned char* lds, int tid, int wave, int lane) {
    const bf16_t* qkv = (const bf16_t*)(p.ws() + WS_BIG);
    const bf16_t* vt = (const bf16_t*)(p.ws() + WS_BIG + BIG_VT);
    bf16_t* O = (bf16_t*)(p.ws() + WS_HA);
    LAS bf16_t* KsB = (LAS bf16_t*)lds;
    LAS bf16_t* VsB = KsB + 2 * 64 * 72;
    const int l15 = lane & 15, g = lane >> 4, hg = wave >> 1, qh = wave & 1;
    const int rowi = tid >> 3, piece = tid & 7;
    for (int unit = blockIdx.x; unit < NBATCH * 4 * 36; unit += gridDim.x) {
        const int qblk = unit % 36, bk = unit / 36, kvh = bk & 3, b = bk >> 2, hq = kvh * 4 + hg;
        const int row0 = b * TT + qblk * 64 + qh * 32;
        bf16x8 qf[2][2];
#pragma unroll
        for (int mt = 0; mt < 2; ++mt)
#pragma unroll
            for (int ks = 0; ks < 2; ++ks) qf[mt][ks] = *(const bf16x8*)(qkv + (size_t)(row0 + mt * 16 + l15) * 1536 + hq * 64 + ks * 32 + g * 8);
        const float sink2 = p.in(14)[hq] * 1.4426950408889634f;
        float mrow[2], lrow[2]; f32x4 oacc[4][2];
#pragma unroll
        for (int mt = 0; mt < 2; ++mt) {
            mrow[mt] = sink2; lrow[mt] = (g == 0) ? 1.f : 0.f;
#pragma unroll
            for (int md = 0; md < 4; ++md) oacc[md][mt] = (f32x4){0.f, 0.f, 0.f, 0.f};
        }
        int lo = 0, ntiles = 4;
        if (qblk >= 4) { lo = qblk - 2 < 4 ? 4 : qblk - 2; const int hi = qblk + 2 > 35 ? 35 : qblk + 2; ntiles = 4 + (hi - lo + 1); }
        const bf16_t* kbase = qkv + (size_t)(b * TT + rowi) * 1536 + 1024 + kvh * 64 + piece * 8;
        const bf16_t* vbase = vt + ((size_t)(b * 4 + kvh) * 64 + rowi) * TT + piece * 8;
        u32x4 kreg = *(const u32x4*)(kbase), vreg = *(const u32x4*)(vbase);
        __syncthreads();
        *(LAS u32x4*)(KsB + rowi * 72 + piece * 8) = kreg;
        *(LAS u32x4*)(VsB + rowi * 72 + piece * 8) = vreg;
        __syncthreads();
        for (int it = 0; it < ntiles; ++it) {
            const int kt = it < 4 ? it : lo + it - 4;
            const LAS bf16_t* Ks = KsB + (it & 1) * (64 * 72);
            const LAS bf16_t* Vs = VsB + (it & 1) * (64 * 72);
            if (it + 1 < ntiles) {
                const int kn = (it + 1) < 4 ? (it + 1) : lo + it + 1 - 4;
                kreg = *(const u32x4*)(kbase + (size_t)kn * 64 * 1536);
                vreg = *(const u32x4*)(vbase + kn * 64);
            }
            f32x4 sacc[4][2];
#pragma unroll
            for (int nt = 0; nt < 4; ++nt) { sacc[nt][0] = (f32x4){0.f, 0.f, 0.f, 0.f}; sacc[nt][1] = sacc[nt][0]; }
#pragma unroll
            for (int nt = 0; nt < 4; ++nt)
#pragma unroll
                for (int ks = 0; ks < 2; ++ks) {
                    const bf16x8 kf = *(const LAS bf16x8*)(Ks + (nt * 16 + l15) * 72 + ks * 32 + g * 8);
#pragma unroll
                    for (int mt = 0; mt < 2; ++mt) sacc[nt][mt] = MFMA16(kf, qf[mt][ks], sacc[nt][mt]);
                }
            if (kt >= 4) {
#pragma unroll
                for (int mt = 0; mt < 2; ++mt) {
                    const int tq = qblk * 64 + qh * 32 + mt * 16 + l15;
#pragma unroll
                    for (int nt = 0; nt < 4; ++nt)
#pragma unroll
                        for (int j = 0; j < 4; ++j) {
                            const int dd = tq - (kt * 64 + nt * 16 + g * 4 + j);
                            if (dd > 128 || dd < -128) sacc[nt][mt][j] = -1e30f;
                        }
                }
            }
#pragma unroll
            for (int mt = 0; mt < 2; ++mt) {
                float mx = sacc[0][mt][0];
#pragma unroll
                for (int nt = 0; nt < 4; ++nt)
#pragma unroll
                    for (int j = 0; j < 4; ++j) mx = fmaxf(mx, sacc[nt][mt][j]);
                mx = fmaxf(mx, __shfl_xor(mx, 16)); mx = fmaxf(mx, __shfl_xor(mx, 32));
                const float mnew = fmaxf(mrow[mt], mx);
                const float alpha = __builtin_amdgcn_exp2f(mrow[mt] - mnew);
                mrow[mt] = mnew;
                float ls = lrow[mt] * alpha;
#pragma unroll
                for (int nt = 0; nt < 4; ++nt)
#pragma unroll
                    for (int j = 0; j < 4; ++j) { const float pe = __builtin_amdgcn_exp2f(sacc[nt][mt][j] - mnew); sacc[nt][mt][j] = pe; ls += pe; }
                lrow[mt] = ls;
#pragma unroll
                for (int md = 0; md < 4; ++md) oacc[md][mt] *= alpha;
            }
#pragma unroll
            for (int kp = 0; kp < 2; ++kp) {
                bf16x8 pB[2];
#pragma unroll
                for (int mt = 0; mt < 2; ++mt) {
                    const f32x4 x0 = sacc[2 * kp][mt], x1 = sacc[2 * kp + 1][mt];
                    pB[mt] = mk8((u32x2){cvtpk(x0.x, x0.y), cvtpk(x0.z, x0.w)}, (u32x2){cvtpk(x1.x, x1.y), cvtpk(x1.z, x1.w)});
                }
#pragma unroll
                for (int md = 0; md < 4; ++md) {
                    const bf16x8 vA = mk8(*(const LAS u32x2*)(Vs + (md * 16 + l15) * 72 + (2 * kp) * 16 + g * 4), *(const LAS u32x2*)(Vs + (md * 16 + l15) * 72 + (2 * kp + 1) * 16 + g * 4));
#pragma unroll
                    for (int mt = 0; mt < 2; ++mt) oacc[md][mt] = MFMA16(vA, pB[mt], oacc[md][mt]);
                }
            }
            if (it + 1 < ntiles) {
                *(LAS u32x4*)(KsB + ((it + 1) & 1) * (64 * 72) + rowi * 72 + piece * 8) = kreg;
                *(LAS u32x4*)(VsB + ((it + 1) & 1) * (64 * 72) + rowi * 72 + piece * 8) = vreg;
            }
            __syncthreads();
        }
#pragma unroll
        for (int mt = 0; mt < 2; ++mt) {
            float lt = lrow[mt]; lt += __shfl_xor(lt, 16); lt += __shfl_xor(lt, 32);
            const float inv = 1.f / lt;
            bf16_t* o = O + (size_t)(row0 + mt * 16 + l15) * 1024 + hq * 64 + g * 4;
#pragma unroll
            for (int md = 0; md < 4; ++md) { const f32x4 ov = oacc[md][mt] * inv; *(u32x2*)(o + md * 16) = (u32x2){cvtpk(ov.x, ov.y), cvtpk(ov.z, ov.w)}; }
        }
    }
}

template <int KIND> DI void chunk_scan_phase(const PZ& p, LAS unsigned char* lds, int tid, int wave, int lane_in) {
    constexpr int SLOT_BYTES = 73216, OFF_QD = 0, OFF_KI = 17408, OFF_KET = 34816, OFF_VT = 53248, OFF_SM = 71680;
    bf16_t* big = (bf16_t*)(p.ws() + WS_BIG);
    const float* Tg = (const float*)(p.ws() + WS_T);
    const float* LBv = (const float*)(p.ws() + WS_SMALL) + 2048;
    const int slot = wave >> 2, w4 = wave & 3;
    LAS unsigned char* sl = lds + slot * SLOT_BYTES;
    LAS bf16_t* Qd = (LAS bf16_t*)(sl + OFF_QD); LAS bf16_t* Ki = (LAS bf16_t*)(sl + OFF_KI); LAS bf16_t* Ab = Ki;
    LAS bf16_t* KeT = (LAS bf16_t*)(sl + OFF_KET); LAS bf16_t* Vt = (LAS bf16_t*)(sl + OFF_VT);
    LAS float* hs = (LAS float*)(sl + OFF_SM); LAS float* dc = hs + 256;
    LAS float* Tl = (LAS float*)(sl + OFF_QD);
    for (int ub = blockIdx.x; ub < 256; ub += gridDim.x) {
        const int st0 = tid & 255;
        const int u = ub * 2 + slot, dir = u & 1, b = u >> 4;
        int qcol0, kcol0, vcol0, ocol0;
        if (KIND == 0) { const int vh = (u >> 1) & 1, h = (u >> 2) & 3; qcol0 = h * 128; kcol0 = 512 + h * 128; vcol0 = 1024 + h * 256 + vh * 128; ocol0 = 2048 + dir * 1024 + h * 256 + vh * 128; }
        else { const int h = (u >> 1) & 7; qcol0 = h * 128; kcol0 = 1024 + dir * 1024 + h * 128; vcol0 = 3072 + h * 128; ocol0 = kcol0; }
        float gu[16], gbias = 0.f, lbv = 0.f;
        if (KIND == 0) {
            const int hcol = qcol0 + (st0 & 127);
#pragma unroll
            for (int r = 0; r < 16; ++r) gu[r] = p.in(17)[((size_t)dir * 16 + r) * 512 + hcol];
            gbias = p.in(18)[dir * 512 + hcol];
        } else {
#pragma unroll
            for (int r = 0; r < 16; ++r) gu[r] = 0.f;
            lbv = LBv[qcol0 + (st0 & 127)];
        }
        const int sgn = dir ? -1 : 1;
        f32x4 S[8][2];
#pragma unroll
        for (int i = 0; i < 8; ++i) { S[i][0] = (f32x4){0.f, 0.f, 0.f, 0.f}; S[i][1] = S[i][0]; }
        unsigned pa[16], pq[16], pv[16]; f32x4 tpre = (f32x4){0.f, 0.f, 0.f, 0.f};
#define CS_PREFETCH(cc) do { \
            const long mcn_ = (long)b * TT + tok_of(dir, (cc) * 64); \
            const bf16_t* rp_ = big + (mcn_ + sgn * (32 * (st0 >> 7))) * 4096 + (st0 & 127); const long stp_ = (long)sgn * 4096; \
            _Pragma("unroll") for (int i2 = 0; i2 < 16; ++i2) { const bf16_t* r0_ = rp_ + stp_ * (2 * i2); const bf16_t* r1_ = r0_ + stp_; \
                pa[i2] = (unsigned)r0_[kcol0] | ((unsigned)r1_[kcol0] << 16); pq[i2] = (unsigned)r0_[qcol0] | ((unsigned)r1_[qcol0] << 16); pv[i2] = (unsigned)r0_[vcol0] | ((unsigned)r1_[vcol0] << 16); } \
            if (KIND == 0) tpre = *(const f32x4*)(Tg + (mcn_ + sgn * (st0 >> 2)) * 32 + dir * 16 + (st0 & 3) * 4); } while (0)
#define CS_UNPK(arr, i) __uint_as_float(((i) & 1) ? ((arr)[(i) >> 1] & 0xffff0000u) : ((arr)[(i) >> 1] << 16))
        CS_PREFETCH(0);
        for (int c = 0; c < TT / 64; ++c) {
            int ln = lane_in, stv = tid & 255; asm volatile("" : "+v"(ln), "+v"(stv));
            const int lane = ln, l15 = lane & 15, g = lane >> 4, st = stv, d = st & 127, hf = st >> 7;
            const long mc0 = (long)b * TT + tok_of(dir, c * 64);
            if (KIND == 0) { *(LAS f32x4*)(Tl + (st >> 2) * 16 + (st & 3) * 4) = tpre; __syncthreads(); }
            float bc[32];
            float run = 0.f;
#pragma unroll
            for (int i = 0; i < 32; ++i) {
                float gl;
                if (KIND == 0) {
                    float z = gbias;
#pragma unroll
                    for (int r4 = 0; r4 < 4; ++r4) { const f32x4 tv = *(const LAS f32x4*)(Tl + (32 * hf + i) * 16 + r4 * 4); z += tv.x * gu[4 * r4] + tv.y * gu[4 * r4 + 1] + tv.z * gu[4 * r4 + 2] + tv.w * gu[4 * r4 + 3]; }
                    gl = (fminf(z, 0.f) - __logf(1.f + __expf(-fabsf(z)))) * 0.0625f;
                } else {
                    const float pf = CS_UNPK(pa, i);
                    const float f = lbv + (1.f - lbv) * __builtin_amdgcn_rcpf(1.f + __expf(-pf));
                    gl = __logf(f);
                }
                run += gl; bc[i] = run;
            }
            hs[hf * 128 + d] = run;
            __syncthreads();
            const float boff = hf ? hs[d] : 0.f, btot = hs[d] + hs[128 + d];
            const float ebt = __expf(btot);
            if (hf == 0) dc[d] = ebt;
#pragma unroll
            for (int j8 = 0; j8 < 4; ++j8) {
                float ke[8];
#pragma unroll
                for (int i8 = 0; i8 < 8; ++i8) {
                    const int i = j8 * 8 + i8;
                    const float bb = bc[i] + boff;
                    float q = CS_UNPK(pq, i);
                    if (KIND == 0) q *= 0.08838834764831845f;
                    float k;
                    if (KIND == 0) k = CS_UNPK(pa, i);
                    else k = 1.f - __expf(bc[i] - (i ? bc[i > 0 ? i - 1 : 0] : 0.f));
                    const float eb = __expf(bb);
                    Qd[(32 * hf + i) * 136 + d] = f2bf(q * eb);
                    Ki[(32 * hf + i) * 136 + d] = f2bf(k * __builtin_amdgcn_rcpf(eb));
                    ke[i8] = k * (ebt * __builtin_amdgcn_rcpf(eb));
                }
                *(LAS u32x4*)(KeT + d * 72 + 32 * hf + 8 * j8) = (u32x4){cvtpk(ke[0], ke[1]), cvtpk(ke[2], ke[3]), cvtpk(ke[4], ke[5]), cvtpk(ke[6], ke[7])};
                *(LAS u32x4*)(Vt + d * 72 + 32 * hf + 8 * j8) = (u32x4){pv[4 * j8], pv[4 * j8 + 1], pv[4 * j8 + 2], pv[4 * j8 + 3]};
            }
            if (c + 1 < TT / 64) CS_PREFETCH(c + 1);
            __syncthreads();
            {
                f32x4 aacc[4];
#pragma unroll
                for (int nt = 0; nt < 4; ++nt) aacc[nt] = (f32x4){0.f, 0.f, 0.f, 0.f};
#pragma unroll
                for (int ks = 0; ks < 4; ++ks) {
                    const bf16x8 a = *(const LAS bf16x8*)(Qd + (w4 * 16 + l15) * 136 + ks * 32 + g * 8);
#pragma unroll
                    for (int nt = 0; nt < 4; ++nt) { const bf16x8 bfr = *(const LAS bf16x8*)(Ki + (nt * 16 + l15) * 136 + ks * 32 + g * 8); aacc[nt] = MFMA16(a, bfr, aacc[nt]); }
                }
                __syncthreads();
#pragma unroll
                for (int nt = 0; nt < 4; ++nt)
#pragma unroll
                    for (int j = 0; j < 4; ++j) { const int t = w4 * 16 + g * 4 + j, s2 = nt * 16 + l15; Ab[t * 72 + s2] = f2bf(s2 <= t ? aacc[nt][j] : 0.f); }
            }
            __syncthreads();
            bf16x8 sfr[4][2];
#pragma unroll
            for (int kp = 0; kp < 4; ++kp)
#pragma unroll
                for (int n2 = 0; n2 < 2; ++n2) {
                    const f32x4 x0 = S[2 * kp][n2], x1 = S[2 * kp + 1][n2];
                    const u32x4 w = (u32x4){cvtpk(x0.x, x0.y), cvtpk(x0.z, x0.w), cvtpk(x1.x, x1.y), cvtpk(x1.z, x1.w)};
                    sfr[kp][n2] = __builtin_bit_cast(bf16x8, w);
                }
#pragma unroll
            for (int mt = 0; mt < 4; ++mt) {
                f32x4 oacc[2]; oacc[0] = (f32x4){0.f, 0.f, 0.f, 0.f}; oacc[1] = oacc[0];
#pragma unroll
                for (int ks = 0; ks < 2; ++ks) {
                    const bf16x8 a = *(const LAS bf16x8*)(Ab + (mt * 16 + l15) * 72 + ks * 32 + g * 8);
#pragma unroll
                    for (int n2 = 0; n2 < 2; ++n2) { const bf16x8 bfr = *(const LAS bf16x8*)(Vt + (w4 * 32 + n2 * 16 + l15) * 72 + ks * 32 + g * 8); oacc[n2] = MFMA16(a, bfr, oacc[n2]); }
                }
#pragma unroll
                for (int kp = 0; kp < 4; ++kp) {
                    const u32x2 lo = *(const LAS u32x2*)(Qd + (mt * 16 + l15) * 136 + (2 * kp) * 16 + g * 4);
                    const u32x2 hi = *(const LAS u32x2*)(Qd + (mt * 16 + l15) * 136 + (2 * kp + 1) * 16 + g * 4);
                    const bf16x8 a = __builtin_bit_cast(bf16x8, ((u32x4){lo.x, lo.y, hi.x, hi.y}));
#pragma unroll
                    for (int n2 = 0; n2 < 2; ++n2) oacc[n2] = MFMA16(a, sfr[kp][n2], oacc[n2]);
                }
#pragma unroll
                for (int j = 0; j < 4; ++j) {
                    const long m = mc0 + sgn * (mt * 16 + g * 4 + j);
#pragma unroll
                    for (int n2 = 0; n2 < 2; ++n2) big[m * 4096 + ocol0 + w4 * 32 + n2 * 16 + l15] = f2bf(oacc[n2][j]);
                }
            }
#pragma unroll
            for (int md = 0; md < 8; ++md) {
                const f32x4 dv = *(const LAS f32x4*)(dc + md * 16 + g * 4);
                S[md][0] *= dv; S[md][1] *= dv;
#pragma unroll
                for (int ks = 0; ks < 2; ++ks) {
                    const bf16x8 a = *(const LAS bf16x8*)(KeT + (md * 16 + l15) * 72 + ks * 32 + g * 8);
#pragma unroll
                    for (int n2 = 0; n2 < 2; ++n2) { const bf16x8 bfr = *(const LAS bf16x8*)(Vt + (w4 * 32 + n2 * 16 + l15) * 72 + ks * 32 + g * 8); S[md][n2] = MFMA16(a, bfr, S[md][n2]); }
                }
            }
            __syncthreads();
        }
    }
}
#undef CS_PREFETCH
#undef CS_UNPK


DI void gla_scan_phase(const PZ& p, LAS unsigned char* lds, int tid, int wave, int lane_in) {
    constexpr int OFF_QD = 0, OFF_KI = 17408, OFF_KET = 34816, OFF_A = 53248, OFF_VT = 62464, OFF_HS = 99328, OFF_DC = 101376, OFF_T = 101888;
    bf16_t* big = (bf16_t*)(p.ws() + WS_BIG);
    const float* Tg = (const float*)(p.ws() + WS_T);
    LAS bf16_t* Qd = (LAS bf16_t*)(lds + OFF_QD); LAS bf16_t* Ki = (LAS bf16_t*)(lds + OFF_KI); LAS bf16_t* KeT = (LAS bf16_t*)(lds + OFF_KET);
    LAS bf16_t* Ab = (LAS bf16_t*)(lds + OFF_A); LAS bf16_t* Vt = (LAS bf16_t*)(lds + OFF_VT);
    LAS float* hs = (LAS float*)(lds + OFF_HS); LAS float* dc = (LAS float*)(lds + OFF_DC); LAS float* Tl = (LAS float*)(lds + OFF_T);
    for (int u = blockIdx.x; u < 256; u += gridDim.x) {
        const int dir = u & 1, h = (u >> 1) & 3, b = u >> 3;
        const int qcol0 = h * 128, kcol0 = 512 + h * 128, vcol0 = 1024 + h * 256, ocol0 = 2048 + dir * 1024 + h * 256;
        const int d0 = tid & 127, q40 = tid >> 7, vv0 = tid & 255, hf20 = tid >> 8;
        float gu[16];
#pragma unroll
        for (int r = 0; r < 16; ++r) gu[r] = p.in(17)[((size_t)dir * 16 + r) * 512 + qcol0 + d0];
        const float gbias = p.in(18)[dir * 512 + qcol0 + d0];
        const int sgn = dir ? -1 : 1;
        f32x4 S[8][2];
#pragma unroll
        for (int i = 0; i < 8; ++i) { S[i][0] = (f32x4){0.f, 0.f, 0.f, 0.f}; S[i][1] = S[i][0]; }
        unsigned pa[8], pq[8], pv[16]; f32x4 tpre = (f32x4){0.f, 0.f, 0.f, 0.f};
#define GS_PREFETCH(cc) do { \
            const long mcn_ = (long)b * TT + tok_of(dir, (cc) * 64); const long stp_ = (long)sgn * 4096; \
            const bf16_t* rp_ = big + (mcn_ + sgn * (16 * q40)) * 4096 + d0; \
            _Pragma("unroll") for (int i2 = 0; i2 < 8; ++i2) { const bf16_t* r0_ = rp_ + stp_ * (2 * i2); const bf16_t* r1_ = r0_ + stp_; \
                pa[i2] = (unsigned)r0_[kcol0] | ((unsigned)r1_[kcol0] << 16); pq[i2] = (unsigned)r0_[qcol0] | ((unsigned)r1_[qcol0] << 16); } \
            const bf16_t* vp_ = big + (mcn_ + sgn * (32 * hf20)) * 4096 + vcol0 + vv0; \
            _Pragma("unroll") for (int i2 = 0; i2 < 16; ++i2) { const bf16_t* r0_ = vp_ + stp_ * (2 * i2); pv[i2] = (unsigned)r0_[0] | ((unsigned)r0_[stp_] << 16); } \
            if (tid < 256) tpre = *(const f32x4*)(Tg + (mcn_ + sgn * (tid >> 2)) * 32 + dir * 16 + (tid & 3) * 4); } while (0)
#define GS_UNPK(arr, i) __uint_as_float(((i) & 1) ? ((arr)[(i) >> 1] & 0xffff0000u) : ((arr)[(i) >> 1] << 16))
        GS_PREFETCH(0);
        __syncthreads();
        if (tid < 256) *(LAS f32x4*)(Tl + (tid >> 2) * 16 + (tid & 3) * 4) = tpre;
        __syncthreads();
        for (int c = 0; c < TT / 64; ++c) {
            int ln = lane_in, tv_ = tid; asm volatile("" : "+v"(ln), "+v"(tv_));
            const int lane = ln, l15 = lane & 15, g = lane >> 4, d = tv_ & 127, q4 = tv_ >> 7, vv = tv_ & 255, hf2 = tv_ >> 8;
            const long mc0 = (long)b * TT + tok_of(dir, c * 64);
            float bc[16];
            float run = 0.f;
#pragma unroll
            for (int i = 0; i < 16; ++i) {
                float z = gbias;
#pragma unroll
                for (int r4 = 0; r4 < 4; ++r4) { const f32x4 tv = *(const LAS f32x4*)(Tl + (16 * q4 + i) * 16 + r4 * 4); z += tv.x * gu[4 * r4] + tv.y * gu[4 * r4 + 1] + tv.z * gu[4 * r4 + 2] + tv.w * gu[4 * r4 + 3]; }
                run += (fminf(z, 0.f) - __logf(1.f + __expf(-fabsf(z)))) * 0.0625f; bc[i] = run;
            }
            hs[q4 * 128 + d] = run;
            __syncthreads();
            const float h0 = hs[d], h1 = hs[128 + d], h2 = hs[256 + d], h3 = hs[384 + d];
            const float boff = (q4 > 0 ? h0 : 0.f) + (q4 > 1 ? h1 : 0.f) + (q4 > 2 ? h2 : 0.f), btot = (h0 + h1) + (h2 + h3);
            const float ebt = __expf(btot);
            if (q4 == 0) dc[d] = ebt;
#pragma unroll
            for (int j8 = 0; j8 < 2; ++j8) {
                float ke[8];
#pragma unroll
                for (int i8 = 0; i8 < 8; ++i8) {
                    const int i = j8 * 8 + i8;
                    const float bb = bc[i] + boff;
                    const float q = GS_UNPK(pq, i) * 0.08838834764831845f, k = GS_UNPK(pa, i);
                    const float eb = __expf(bb);
                    Qd[(16 * q4 + i) * 136 + d] = f2bf(q * eb);
                    Ki[(16 * q4 + i) * 136 + d] = f2bf(k * __builtin_amdgcn_rcpf(eb));
                    ke[i8] = k * (ebt * __builtin_amdgcn_rcpf(eb));
                }
                *(LAS u32x4*)(KeT + d * 72 + 16 * q4 + 8 * j8) = (u32x4){cvtpk(ke[0], ke[1]), cvtpk(ke[2], ke[3]), cvtpk(ke[4], ke[5]), cvtpk(ke[6], ke[7])};
            }
#pragma unroll
            for (int j8 = 0; j8 < 4; ++j8) *(LAS u32x4*)(Vt + vv * 72 + 32 * hf2 + 8 * j8) = (u32x4){pv[4 * j8], pv[4 * j8 + 1], pv[4 * j8 + 2], pv[4 * j8 + 3]};
            if (c + 1 < TT / 64) GS_PREFETCH(c + 1);
            __syncthreads();
            {
                const int tt = wave >> 1, s0 = (wave & 1) * 2;
                f32x4 aacc[2]; aacc[0] = (f32x4){0.f, 0.f, 0.f, 0.f}; aacc[1] = aacc[0];
#pragma unroll
                for (int ks = 0; ks < 4; ++ks) {
                    const bf16x8 a = *(const LAS bf16x8*)(Qd + (tt * 16 + l15) * 136 + ks * 32 + g * 8);
#pragma unroll
                    for (int n2 = 0; n2 < 2; ++n2) { const bf16x8 bfr = *(const LAS bf16x8*)(Ki + ((s0 + n2) * 16 + l15) * 136 + ks * 32 + g * 8); aacc[n2] = MFMA16(a, bfr, aacc[n2]); }
                }
#pragma unroll
                for (int n2 = 0; n2 < 2; ++n2)
#pragma unroll
                    for (int j = 0; j < 4; ++j) { const int t = tt * 16 + g * 4 + j, s2 = (s0 + n2) * 16 + l15; Ab[t * 72 + s2] = f2bf(s2 <= t ? aacc[n2][j] : 0.f); }
            }
            __syncthreads();
            bf16x8 sfr[4][2];
#pragma unroll
            for (int kp = 0; kp < 4; ++kp)
#pragma unroll
                for (int n2 = 0; n2 < 2; ++n2) {
                    const f32x4 x0 = S[2 * kp][n2], x1 = S[2 * kp + 1][n2];
                    sfr[kp][n2] = mk8((u32x2){cvtpk(x0.x, x0.y), cvtpk(x0.z, x0.w)}, (u32x2){cvtpk(x1.x, x1.y), cvtpk(x1.z, x1.w)});
                }
#pragma unroll
            for (int mt = 0; mt < 4; ++mt) {
                f32x4 oacc[2]; oacc[0] = (f32x4){0.f, 0.f, 0.f, 0.f}; oacc[1] = oacc[0];
#pragma unroll
                for (int ks = 0; ks < 2; ++ks) {
                    const bf16x8 a = *(const LAS bf16x8*)(Ab + (mt * 16 + l15) * 72 + ks * 32 + g * 8);
#pragma unroll
                    for (int n2 = 0; n2 < 2; ++n2) { const bf16x8 bfr = *(const LAS bf16x8*)(Vt + (wave * 32 + n2 * 16 + l15) * 72 + ks * 32 + g * 8); oacc[n2] = MFMA16(a, bfr, oacc[n2]); }
                }
#pragma unroll
                for (int kp = 0; kp < 4; ++kp) {
                    const bf16x8 a = mk8(*(const LAS u32x2*)(Qd + (mt * 16 + l15) * 136 + (2 * kp) * 16 + g * 4), *(const LAS u32x2*)(Qd + (mt * 16 + l15) * 136 + (2 * kp + 1) * 16 + g * 4));
#pragma unroll
                    for (int n2 = 0; n2 < 2; ++n2) oacc[n2] = MFMA16(a, sfr[kp][n2], oacc[n2]);
                }
#pragma unroll
                for (int j = 0; j < 4; ++j) {
                    const long m = mc0 + sgn * (mt * 16 + g * 4 + j);
#pragma unroll
                    for (int n2 = 0; n2 < 2; ++n2) big[m * 4096 + ocol0 + wave * 32 + n2 * 16 + l15] = f2bf(oacc[n2][j]);
                }
            }
#pragma unroll
            for (int md = 0; md < 8; ++md) {
                const f32x4 dv = *(const LAS f32x4*)(dc + md * 16 + g * 4);
                S[md][0] *= dv; S[md][1] *= dv;
#pragma unroll
                for (int ks = 0; ks < 2; ++ks) {
                    const bf16x8 a = *(const LAS bf16x8*)(KeT + (md * 16 + l15) * 72 + ks * 32 + g * 8);
#pragma unroll
                    for (int n2 = 0; n2 < 2; ++n2) { const bf16x8 bfr = *(const LAS bf16x8*)(Vt + (wave * 32 + n2 * 16 + l15) * 72 + ks * 32 + g * 8); S[md][n2] = MFMA16(a, bfr, S[md][n2]); }
                }
            }
            if (tv_ < 256) *(LAS f32x4*)(Tl + (tv_ >> 2) * 16 + (tv_ & 3) * 4) = tpre;
            __syncthreads();
        }
    }
#undef GS_PREFETCH
#undef GS_UNPK
}

template <int KIND> DI void post_diag_phase(const PZ& p, int wave, int lane) {
    const int gw = blockIdx.x * 8 + wave, NGW = gridDim.x * 8;
    const bf16_t* big = (const bf16_t*)(p.ws() + WS_BIG);
    const bf16_t* OG = (const bf16_t*)(p.ws() + WS_Y);
    bf16_t* HA = (bf16_t*)(p.ws() + WS_HA);
    const float* gn = KIND == 0 ? p.in(19) : p.in(40);
    for (int m = gw; m < MTOK; m += NGW) {
        if (KIND == 1 && (m % TT) < NCTX) continue;
        const bf16_t* of = big + (size_t)m * 4096 + (KIND == 0 ? 2048 : 1024);
#pragma unroll
        for (int j = 0; j < 4; ++j) {
            const f32x4 o = bf4_to_f4(*((const u32x2*)of + lane + 64 * j)) + bf4_to_f4(*((const u32x2*)(of + 1024) + lane + 64 * j));
            float ss = o.x * o.x + o.y * o.y + o.z * o.z + o.w * o.w;
            float rstd; f32x4 g4;
            if (KIND == 0) { rstd = rsqrtf(wave_sum(ss) * (1.f / 256.f) + 1e-6f); g4 = *((const f32x4*)gn + lane); }
            else { ss = red16(ss); ss += __shfl_xor(ss, 16); rstd = rsqrtf(ss * (1.f / 128.f) + 1e-6f); g4 = *((const f32x4*)gn + (lane & 31)); }
            const f32x4 og = bf4_to_f4(*((const u32x2*)(OG + (size_t)m * 1024) + lane + 64 * j));
            *((u32x2*)(HA + (size_t)m * 1024) + lane + 64 * j) = f4_to_bf4(o * rstd * g4 * og);
        }
    }
}

DI f32x4 prod16(f32x4 X, f32x4 Y, LAS float* T1, int l15, int g) {
#pragma unroll
    for (int j = 0; j < 4; ++j) T1[(g * 4 + j) * 20 + l15] = X[j];
    LDS_WAIT();
    const f32x4 xr = *(const LAS f32x4*)(T1 + l15 * 20 + g * 4);
    LDS_WAIT();
    const unsigned xh01 = cvtpk(xr.x, xr.y), xh23 = cvtpk(xr.z, xr.w);
    const unsigned xl01 = cvtpk(xr.x - __uint_as_float(xh01 << 16), xr.y - __uint_as_float(xh01 & 0xffff0000u));
    const unsigned xl23 = cvtpk(xr.z - __uint_as_float(xh23 << 16), xr.w - __uint_as_float(xh23 & 0xffff0000u));
    const unsigned yh01 = cvtpk(Y.x, Y.y), yh23 = cvtpk(Y.z, Y.w);
    const unsigned yl01 = cvtpk(Y.x - __uint_as_float(yh01 << 16), Y.y - __uint_as_float(yh01 & 0xffff0000u));
    const unsigned yl23 = cvtpk(Y.z - __uint_as_float(yh23 << 16), Y.w - __uint_as_float(yh23 & 0xffff0000u));
    const u32x2 z2 = (u32x2){0u, 0u};
    const bf16x8 ah = mk8((u32x2){xh01, xh23}, z2), al = mk8((u32x2){xl01, xl23}, z2), bh = mk8((u32x2){yh01, yh23}, z2), bl = mk8((u32x2){yl01, yl23}, z2);
    f32x4 acc = (f32x4){0.f, 0.f, 0.f, 0.f};
    acc = MFMA16(ah, bh, acc); acc = MFMA16(ah, bl, acc); acc = MFMA16(al, bh, acc);
    return acc;
}
DI void prod16x2(f32x4 X, f32x4 Y1, f32x4 Y2, LAS float* T1, int l15, int g, f32x4& R1, f32x4& R2) {
#pragma unroll
    for (int j = 0; j < 4; ++j) T1[(g * 4 + j) * 20 + l15] = X[j];
    LDS_WAIT();
    const f32x4 xr = *(const LAS f32x4*)(T1 + l15 * 20 + g * 4);
    LDS_WAIT();
    const unsigned xh01 = cvtpk(xr.x, xr.y), xh23 = cvtpk(xr.z, xr.w);
    const unsigned xl01 = cvtpk(xr.x - __uint_as_float(xh01 << 16), xr.y - __uint_as_float(xh01 & 0xffff0000u));
    const unsigned xl23 = cvtpk(xr.z - __uint_as_float(xh23 << 16), xr.w - __uint_as_float(xh23 & 0xffff0000u));
    const u32x2 z2 = (u32x2){0u, 0u};
    const bf16x8 ah = mk8((u32x2){xh01, xh23}, z2), al = mk8((u32x2){xl01, xl23}, z2);
    f32x4 acc[2]; const f32x4 Ys[2] = {Y1, Y2};
#pragma unroll
    for (int q = 0; q < 2; ++q) {
        const f32x4 Y = Ys[q];
        const unsigned yh01 = cvtpk(Y.x, Y.y), yh23 = cvtpk(Y.z, Y.w);
        const unsigned yl01 = cvtpk(Y.x - __uint_as_float(yh01 << 16), Y.y - __uint_as_float(yh01 & 0xffff0000u));
        const unsigned yl23 = cvtpk(Y.z - __uint_as_float(yh23 << 16), Y.w - __uint_as_float(yh23 & 0xffff0000u));
        const bf16x8 bh = mk8((u32x2){yh01, yh23}, z2), bl = mk8((u32x2){yl01, yl23}, z2);
        acc[q] = (f32x4){0.f, 0.f, 0.f, 0.f};
        acc[q] = MFMA16(ah, bh, acc[q]); acc[q] = MFMA16(ah, bl, acc[q]); acc[q] = MFMA16(al, bh, acc[q]);
    }
    R1 = acc[0]; R2 = acc[1];
}
DI void pair_sync(volatile LAS int* fl, int half, int seq) {
    asm volatile("s_waitcnt lgkmcnt(0)" ::: "memory");
    fl[half] = seq;
    while (fl[1 - half] < seq) __builtin_amdgcn_s_sleep(1);
    asm volatile("s_waitcnt lgkmcnt(0)" ::: "memory");
}
DI void rwkv_chunk_scan_phase(const PZ& p, LAS unsigned char* lds, int wave, int lane) {
    const int slot = wave & 3, half = wave >> 2;
    LAS unsigned char* wl = lds + slot * 26368;
    LAS bf16_t* AH = (LAS bf16_t*)wl; LAS bf16_t* RH = AH + 16 * 72; LAS bf16_t* BH = RH + 16 * 72; LAS bf16_t* KH = BH + 16 * 72;
    LAS bf16_t* BKT = KH + 16 * 72;
    LAS bf16_t* SMT = BKT + 64 * 40;
    LAS float* T1 = (LAS float*)(wl + 16640);
    LAS float* GC = (LAS float*)(wl + 17920);
    LAS float* PRM = (LAS float*)(wl + 18176);
    LAS bf16_t* RK = (LAS bf16_t*)(wl + 19456);
    LAS float* EX = (LAS float*)(wl + 25856);
    volatile LAS int* fl = (volatile LAS int*)(wl + 26112);
    if (lane == 0) fl[half] = 0;
    __syncthreads();
    int seq = 0;
    const bf16_t* rkv = (const bf16_t*)(p.ws() + WS_BIG);
    const bf16_t* LR = (const bf16_t*)(p.ws() + WS_BIG + BIG_LR);
    float* BS = (float*)(p.ws() + WS_BIG + BIG_BS);
    const u32x2 z2 = (u32x2){0u, 0u};
    for (int u = blockIdx.x * 4 + slot; u < NBATCH * 16 * 2; u += gridDim.x * 4) {
        const int dir = u & 1, h = (u >> 1) & 15, b = u >> 5;
        const int sgn = dir ? -1 : 1;
        bf16_t* Yo = (bf16_t*)(p.ws() + (dir == 0 ? WS_HA : WS_Y));
        const bf16_t* wupT = (const bf16_t*)(p.ws() + WS_SMALL + 65536) + ((size_t)dir * 1024 + h * 64) * 64;
        const bf16_t* aupT = (const bf16_t*)(p.ws() + WS_SMALL + 65536) + ((size_t)(2 + dir) * 1024 + h * 64) * 64;
        pair_sync(fl, half, ++seq);
        if (half == 0) {
            const int hc = h * 64 + lane;
            PRM[lane] = p.in(23)[dir * 1024 + hc]; PRM[64 + lane] = p.in(26)[dir * 1024 + hc]; PRM[128 + lane] = p.in(31)[hc]; PRM[192 + lane] = p.in(32)[hc]; PRM[256 + lane] = p.in(33)[hc];
        }
        f32x4 St[4][4];
#pragma unroll
        for (int i = 0; i < 4; ++i)
#pragma unroll
            for (int k = 0; k < 4; ++k) St[i][k] = (f32x4){0.f, 0.f, 0.f, 0.f};
        u32x4 stg[6]; bf16x8 awd[2], aad[2];
        {
            const long mcn = (long)b * TT + tok_of(dir, 0);
            if (half == 0) {
#pragma unroll
                for (int i = 0; i < 6; ++i) {
                    const int q = lane + 64 * i, t = q / 24, rem = q - 24 * t, mat = rem >> 3, pc = rem & 7;
                    stg[i] = *(const u32x4*)(rkv + (mcn + sgn * t) * 3072 + mat * 1024 + h * 64 + pc * 8);
                }
            } else {
#pragma unroll
                for (int i = 0; i < 6; ++i) stg[i] = (u32x4){0u, 0u, 0u, 0u};
            }
            const long mAn = mcn + sgn * (lane & 15);
#pragma unroll
            for (int ks = 0; ks < 2; ++ks) { awd[ks] = *(const bf16x8*)(LR + mAn * 256 + dir * 64 + ks * 32 + (lane >> 4) * 8); aad[ks] = *(const bf16x8*)(LR + mAn * 256 + 128 + dir * 64 + ks * 32 + (lane >> 4) * 8); }
        }
        for (int chunk = 0; chunk < TT / 16; ++chunk) {
            const long mc0 = (long)b * TT + tok_of(dir, chunk * 16);
            int ln = lane; asm volatile("" : "+v"(ln));
            const int l15 = ln & 15, g = ln >> 4;
            const bf16x8 awd0 = awd[0], awd1 = awd[1], aad0 = aad[0], aad1 = aad[1];
            {
                int lq = ln;
                if (half == 0) {
#pragma unroll
                    for (int i = 0; i < 6; ++i) {
                        const int q = lq + 64 * i, t = q / 24, rem = q - 24 * t, mat = rem >> 3, pc = rem & 7;
                        *(LAS u32x4*)(RK + t * 200 + mat * 64 + pc * 8) = stg[i];
                    }
                }
                if (chunk + 1 < TT / 16) {
                    const long mcn = (long)b * TT + tok_of(dir, (chunk + 1) * 16);
                    if (half == 0) {
#pragma unroll
                        for (int i = 0; i < 6; ++i) {
                            const int q = lq + 64 * i, t = q / 24, rem = q - 24 * t, mat = rem >> 3, pc = rem & 7;
                            stg[i] = *(const u32x4*)(rkv + (mcn + sgn * t) * 3072 + mat * 1024 + h * 64 + pc * 8);
                        }
                    }
                    const long mAn = mcn + sgn * l15;
#pragma unroll
                    for (int ks = 0; ks < 2; ++ks) { awd[ks] = *(const bf16x8*)(LR + mAn * 256 + dir * 64 + ks * 32 + g * 8); aad[ks] = *(const bf16x8*)(LR + mAn * 256 + 128 + dir * 64 + ks * 32 + g * 8); }
                }
            }
            pair_sync(fl, half, ++seq);
            f32x4 accW[2], accA[2];
#pragma unroll
            for (int n2 = 0; n2 < 2; ++n2) {
                const int nt = 2 * half + n2;
                accW[n2] = (f32x4){0.f, 0.f, 0.f, 0.f}; accA[n2] = accW[n2];
#pragma unroll
                for (int ks = 0; ks < 2; ++ks) {
                    const bf16x8 wf = *(const bf16x8*)(wupT + (nt * 16 + l15) * 64 + ks * 32 + g * 8);
                    const bf16x8 af = *(const bf16x8*)(aupT + (nt * 16 + l15) * 64 + ks * 32 + g * 8);
                    accW[n2] = MFMA16(ks ? awd1 : awd0, wf, accW[n2]); accA[n2] = MFMA16(ks ? aad1 : aad0, af, accA[n2]);
                }
            }
            float boff[2], bb[4][2], bC[2];
#pragma unroll
            for (int n2 = 0; n2 < 2; ++n2) {
                const int nt = 2 * half + n2;
                const float w0v = PRM[nt * 16 + l15];
                float lwj[4];
#pragma unroll
                for (int j = 0; j < 4; ++j) {
                    const float xn = -(w0v + accW[n2][j]);
                    const float sp = fmaxf(xn, 0.f) + __logf(1.f + __expf(-fabsf(xn)));
                    lwj[j] = -__expf(-sp - 0.5f);
                }
                const float p0 = lwj[0], p1 = p0 + lwj[1], p2 = p1 + lwj[2], p3 = p2 + lwj[3];
                const float t1 = __shfl(p3, (ln + 48) & 63);
                const float s1 = p3 + (g >= 1 ? t1 : 0.f);
                const float t2 = __shfl(s1, (ln + 32) & 63);
                const float s2 = s1 + (g >= 2 ? t2 : 0.f);
                const float off = s2 - p3;
                bb[0][n2] = p0 + off; bb[1][n2] = p1 + off; bb[2][n2] = p2 + off; bb[3][n2] = p3 + off; boff[n2] = off;
                bC[n2] = __shfl(s2, 48 + l15);
            }
            float av[4][2], kr[4][2], kdv[4][2], rv[4][2];
#pragma unroll
            for (int j = 0; j < 4; ++j) {
                const int t = g * 4 + j;
                float ss = 0.f, bsum = 0.f;
#pragma unroll
                for (int n2 = 0; n2 < 2; ++n2) {
                    const int c = (2 * half + n2) * 16 + l15;
                    const float r_ = bf2f(RK[t * 200 + c]), k_ = bf2f(RK[t * 200 + 64 + c]);
                    const float a_ = __builtin_amdgcn_rcpf(1.f + __expf(-(PRM[64 + c] + accA[n2][j])));
                    kr[j][n2] = k_ * PRM[128 + c]; ss += kr[j][n2] * kr[j][n2]; av[j][n2] = a_; rv[j][n2] = r_;
                    kdv[j][n2] = k_ * (1.f + (a_ - 1.f) * PRM[192 + c]);
                    bsum += r_ * kdv[j][n2] * PRM[256 + c];
                }
                ss = red16(ss); bsum = red16(bsum);
                if (l15 == 0) { EX[(half * 16 + t) * 2] = ss; EX[(half * 16 + t) * 2 + 1] = bsum; }
            }
            pair_sync(fl, half, ++seq);
            float gprev[2] = {1.f, 1.f}; const float gCv[2] = {__expf(bC[0]), __expf(bC[1])};
#pragma unroll
            for (int j = 0; j < 4; ++j) {
                const int t = g * 4 + j;
                const float ss = EX[t * 2] + EX[(16 + t) * 2];
                const float inv = __builtin_amdgcn_rsqf(fmaxf(ss, 1e-24f));
#pragma unroll
                for (int n2 = 0; n2 < 2; ++n2) {
                    const int c = (2 * half + n2) * 16 + l15;
                    const float kk = kr[j][n2] * inv, bq = bb[j][n2];
                    const float gt = __expf(bq), gi = __builtin_amdgcn_rcpf(gt), gm1 = (j == 0) ? __expf(boff[n2]) : gprev[n2], ge = gCv[n2] * gi; gprev[n2] = gt;
                    AH[t * 72 + c] = f2bf(-kk * gm1); RH[t * 72 + c] = f2bf(rv[j][n2] * gt);
                    BH[t * 72 + c] = f2bf(kk * av[j][n2] * gi); KH[t * 72 + c] = f2bf(kdv[j][n2] * gi);
                    BKT[c * 40 + t] = f2bf(kk * av[j][n2] * ge); BKT[c * 40 + 16 + t] = f2bf(kdv[j][n2] * ge);
                }
                if (half == 0 && l15 == 0) BS[((size_t)dir * MTOK + (mc0 + sgn * t)) * 16 + h] = EX[t * 2 + 1] + EX[(16 + t) * 2 + 1];
            }
            if (g == 0) {
#pragma unroll
                for (int n2 = 0; n2 < 2; ++n2) GC[(2 * half + n2) * 16 + l15] = gCv[n2];
            }
            pair_sync(fl, half, ++seq);
            f32x4 Xs[4], Yrs[4]; u32x2 vpk4[4];
#pragma unroll
            for (int nt = 0; nt < 4; ++nt) { Xs[nt] = (f32x4){0.f, 0.f, 0.f, 0.f}; Yrs[nt] = Xs[nt]; vpk4[nt] = z2; }
            if (half == 1) {
                f32x4 Mab = (f32x4){0.f, 0.f, 0.f, 0.f}, Mak = Mab, Nrb = Mab, Nrk = Mab;
#pragma unroll
                for (int ks = 0; ks < 2; ++ks) {
                    const bf16x8 fa = *(const LAS bf16x8*)(AH + l15 * 72 + ks * 32 + g * 8), fr = *(const LAS bf16x8*)(RH + l15 * 72 + ks * 32 + g * 8);
                    const bf16x8 fb = *(const LAS bf16x8*)(BH + l15 * 72 + ks * 32 + g * 8), fk = *(const LAS bf16x8*)(KH + l15 * 72 + ks * 32 + g * 8);
                    Mab = MFMA16(fa, fb, Mab); Mak = MFMA16(fa, fk, Mak); Nrb = MFMA16(fr, fb, Nrb); Nrk = MFMA16(fr, fk, Nrk);
                }
                f32x4 Lm;
#pragma unroll
                for (int j = 0; j < 4; ++j) {
                    const int t = g * 4 + j;
                    if (l15 >= t) { Mab[j] = 0.f; Mak[j] = 0.f; }
                    if (l15 > t) { Nrb[j] = 0.f; Nrk[j] = 0.f; }
                    Lm[j] = (l15 == t ? 1.f : 0.f) + Mab[j];
                }
                {
                    const f32x4 P2 = prod16(Mab, Mab, T1, l15, g);
                    f32x4 D, P4, P8;
                    prod16x2(P2, Lm, P2, T1, l15, g, D, P4); Lm += D;
                    prod16x2(P4, Lm, P4, T1, l15, g, D, P8); Lm += D;
                    Lm += prod16(P8, Lm, T1, l15, g);
                }
#pragma unroll
                for (int j = 0; j < 4; ++j) {
                    const int row = (g * 4 + j) * 72 + l15;
                    SMT[row] = f2bf(Mak[j]); SMT[row + 16] = f2bf(Lm[j]); SMT[row + 32] = f2bf(Nrb[j]); SMT[row + 48] = f2bf(Nrk[j]);
                }
            } else {
#pragma unroll
                for (int nt = 0; nt < 4; ++nt) {
                    const LAS bf16_t* vp = RK + (g * 4) * 200 + 128 + nt * 16 + l15;
                    const unsigned v0 = vp[0], v1 = vp[200], v2 = vp[400], v3 = vp[600];
                    vpk4[nt] = (u32x2){v0 | (v1 << 16), v2 | (v3 << 16)};
                }
                bf16x8 aX[2], aR[2];
#pragma unroll
                for (int kp = 0; kp < 2; ++kp) {
                    aX[kp] = mk8(*(const LAS u32x2*)(AH + l15 * 72 + (2 * kp) * 16 + g * 4), *(const LAS u32x2*)(AH + l15 * 72 + (2 * kp + 1) * 16 + g * 4));
                    aR[kp] = mk8(*(const LAS u32x2*)(RH + l15 * 72 + (2 * kp) * 16 + g * 4), *(const LAS u32x2*)(RH + l15 * 72 + (2 * kp + 1) * 16 + g * 4));
                }
#pragma unroll
                for (int nt = 0; nt < 4; ++nt)
#pragma unroll
                    for (int kp = 0; kp < 2; ++kp) {
                        const f32x4 x0 = St[2 * kp][nt], x1 = St[2 * kp + 1][nt];
                        const bf16x8 sf = mk8((u32x2){cvtpk(x0.x, x0.y), cvtpk(x0.z, x0.w)}, (u32x2){cvtpk(x1.x, x1.y), cvtpk(x1.z, x1.w)});
                        Xs[nt] = MFMA16(aX[kp], sf, Xs[nt]); Yrs[nt] = MFMA16(aR[kp], sf, Yrs[nt]);
                    }
            }
            pair_sync(fl, half, ++seq);
            if (half == 0) {
                const bf16x8 makA = mk8(*(const LAS u32x2*)(SMT + l15 * 72 + g * 4), z2);
                const bf16x8 LA = mk8(*(const LAS u32x2*)(SMT + l15 * 72 + 16 + g * 4), z2);
                const bf16x8 nA = mk8(*(const LAS u32x2*)(SMT + l15 * 72 + 32 + g * 4), *(const LAS u32x2*)(SMT + l15 * 72 + 48 + g * 4));
                bf16x8 cvB[4];
#pragma unroll
                for (int nt = 0; nt < 4; ++nt) {
                    const u32x2 vpk = vpk4[nt];
                    const f32x4 Z = MFMA16(makA, mk8(vpk, z2), Xs[nt]);
                    const f32x4 Cm = MFMA16(LA, mk8((u32x2){cvtpk(Z.x, Z.y), cvtpk(Z.z, Z.w)}, z2), ((f32x4){0.f, 0.f, 0.f, 0.f}));
                    cvB[nt] = mk8((u32x2){cvtpk(Cm.x, Cm.y), cvtpk(Cm.z, Cm.w)}, vpk);
                    const f32x4 Y = MFMA16(nA, cvB[nt], Yrs[nt]);
#pragma unroll
                    for (int j = 0; j < 4; ++j) Yo[(mc0 + sgn * (g * 4 + j)) * 1024 + h * 64 + nt * 16 + l15] = f2bf(Y[j]);
                }
#pragma unroll
                for (int mt = 0; mt < 4; ++mt) {
                    const f32x4 gc4 = *(const LAS f32x4*)(GC + mt * 16 + g * 4);
                    const bf16x8 bkA = mk8(*(const LAS u32x2*)(BKT + (mt * 16 + l15) * 40 + g * 4), *(const LAS u32x2*)(BKT + (mt * 16 + l15) * 40 + 16 + g * 4));
#pragma unroll
                    for (int nt = 0; nt < 4; ++nt) St[mt][nt] = MFMA16(bkA, cvB[nt], St[mt][nt] * gc4);
                }
            }
        }
    }
}
DI void post_rwkv_phase(const PZ& p, int wave, int lane) {
    const int gw = blockIdx.x * 8 + wave, NGW = gridDim.x * 8;
    const bf16_t* rkv = (const bf16_t*)(p.ws() + WS_BIG);
    const float* BS = (const float*)(p.ws() + WS_BIG + BIG_BS);
    bf16_t* HA = (bf16_t*)(p.ws() + WS_HA);
    const bf16_t* YB = (const bf16_t*)(p.ws() + WS_Y);
    for (int m = gw; m < MTOK; m += NGW) {
        f32x4 outv[4];
#pragma unroll
        for (int j = 0; j < 4; ++j) {
            const int head = j * 4 + (lane >> 4);
            const f32x4 y = bf4_to_f4(*((const u32x2*)(HA + (size_t)m * 1024) + lane + 64 * j)) + bf4_to_f4(*((const u32x2*)(YB + (size_t)m * 1024) + lane + 64 * j));
            const float mu = red16(y.x + y.y + y.z + y.w) * (1.f / 64.f);
            const f32x4 d = y - mu;
            const float var = red16(d.x * d.x + d.y * d.y + d.z * d.z + d.w * d.w) * (1.f / 64.f);
            const float rstd = rsqrtf(var + 64e-5f);
            const f32x4 lw = *((const f32x4*)p.in(34) + lane + 64 * j), lb = *((const f32x4*)p.in(35) + lane + 64 * j);
            const float bon = 0.5f * (BS[(size_t)m * 16 + head] + BS[((size_t)MTOK + m) * 16 + head]);
            const f32x4 v = bf4_to_f4(*((const u32x2*)(rkv + (size_t)m * 3072 + 2048) + lane + 64 * j));
            const f32x4 gg = bf4_to_f4(*((const u32x2*)(rkv + (size_t)m * 3072) + lane + 64 * j));
            outv[j] = (d * rstd * lw + lb + v * bon) * gg;
        }
#pragma unroll
        for (int j = 0; j < 4; ++j) *((u32x2*)(HA + (size_t)m * 1024) + lane + 64 * j) = f4_to_bf4(outv[j]);
    }
}

#define XB_TMO      128
#define XB_XCNT(j)  (256  + 64 * (j))
#define XB_XSUB(j)  (1280 + 64 * (j))
#define XB_XGEN(j)  (2304 + 64 * (j))
#define XB_TOP      3328
#define XB_TOPGEN   3392
#define XCD_BAR_WORDS 3456
#define XB_SPIN_CAP (1u << 18)

__device__ __forceinline__ unsigned xb_ld(unsigned* p)              { return __hip_atomic_load(p, __ATOMIC_RELAXED, __HIP_MEMORY_SCOPE_AGENT); }
__device__ __forceinline__ unsigned xb_add(unsigned* p, unsigned v) { return __hip_atomic_fetch_add(p, v, __ATOMIC_RELAXED, __HIP_MEMORY_SCOPE_AGENT); }
__device__ __forceinline__ unsigned xb_xcc_id() { return (unsigned)__builtin_amdgcn_s_getreg((3 << 11) | 20) & 0xFu; }
#define XB_SPIN(cond, bar) do { unsigned _sp = 0; while (cond) { __builtin_amdgcn_s_sleep(1); \
    if ((++_sp & 255u) == 0u) { if (xb_ld(&(bar)[XB_TMO])) break; if (_sp > XB_SPIN_CAP) { atomicAdd(&(bar)[XB_TMO], 1u); break; } } } } while (0)

struct XcdBarrier {
    unsigned* bar; unsigned x;
    volatile LAS unsigned* st;
};

__device__ __forceinline__ XcdBarrier xcd_barrier_post(unsigned* bar, volatile LAS unsigned* st) {
    XcdBarrier b; b.bar = bar; b.x = xb_xcc_id(); b.st = st;
    if (threadIdx.x == 0) (void)xb_add(&bar[XB_XCNT(b.x)], 1u);
    return b;
}
__device__ __forceinline__ void xcd_barrier_complete(unsigned* bar, unsigned x, unsigned& nloc, unsigned& nx) {
    const unsigned G = gridDim.x * gridDim.y * gridDim.z;
    unsigned sum, cnt, mine, sp = 0u;
    for (;;) {
        sum = 0u; cnt = 0u; mine = 0u;
#pragma unroll
        for (unsigned j = 0; j < 16; ++j) { const unsigned c = xb_ld(&bar[XB_XCNT(j)]); sum += c; cnt += (c > 0u) ? 1u : 0u; mine = (j == x) ? c : mine; }
        if (sum == G) break;
        __builtin_amdgcn_s_sleep(1);
        if ((++sp & 255u) == 0u) { if (xb_ld(&bar[XB_TMO])) break; if (sp > XB_SPIN_CAP) { atomicAdd(&bar[XB_TMO], 1u); break; } }
    }
    nloc = mine > 0u ? mine : 1u; nx = cnt > 0u ? cnt : 1u;
}

__device__ __forceinline__ void xcd_barrier(const XcdBarrier& b) {
    asm volatile("s_waitcnt vmcnt(0)" ::: "memory");
    __syncthreads();
    if (threadIdx.x == 0) {
        unsigned* bar = b.bar;
        __builtin_amdgcn_s_waitcnt(0);
        unsigned nloc = b.st[0], nx = b.st[1];
        if (nloc == 0u) { xcd_barrier_complete(bar, b.x, nloc, nx); b.st[0] = nloc; b.st[1] = nx; }
        const unsigned old = xb_add(&bar[XB_XSUB(b.x)], 1u);
        const unsigned gen = old / nloc;
        if (old + 1u == (gen + 1u) * nloc) {
            __builtin_amdgcn_fence(__ATOMIC_RELEASE, "agent");
            asm volatile("s_waitcnt vmcnt(0)" ::: "memory");
            const unsigned og = xb_add(&bar[XB_TOP], 1u);
            const unsigned tg = og / nx;
            if (og + 1u == (tg + 1u) * nx) xb_add(&bar[XB_TOPGEN], 1u);
            else XB_SPIN(xb_ld(&bar[XB_TOPGEN]) == tg, bar);
            __builtin_amdgcn_fence(__ATOMIC_ACQUIRE, "agent");
            xb_add(&bar[XB_XGEN(b.x)], 1u);
            asm volatile("s_waitcnt vmcnt(0)" ::: "memory");
        } else {
            XB_SPIN(xb_ld(&bar[XB_XGEN(b.x)]) == gen, bar);
            __builtin_amdgcn_fence(__ATOMIC_ACQUIRE, "agent");
            asm volatile("s_waitcnt vmcnt(0)" ::: "memory");
        }
    }
    __syncthreads();
}

__constant__ unsigned char kPhaseKind[NPH] = {0, 1, 10, 20, 4, 2, 5, 6, 3, 11, 21, 30, 4, 2, 5, 6, 3, 8, 12, 22, 9, 31, 4, 2, 5, 6, 3, 13, 23, 32, 4, 2, 5, 6, 3};
#ifndef REP_A
#define REP_A 1
#endif
#ifndef REP_B
#define REP_B 1
#endif
#ifndef REP_C
#define REP_C 1
#endif
#ifndef REP_D
#define REP_D 1
#endif
#ifndef REP_E
#define REP_E 1
#endif
#ifndef REP_F
#define REP_F 1
#endif
__constant__ unsigned char kPhaseRep[NPH] = {REP_E, 1, REP_C, REP_A, 1, 1, REP_B, REP_B, 1, REP_C, REP_F, 1, 1, 1, REP_B, REP_B, 1, 1, REP_C, REP_D, 1, 1, 1, 1, REP_B, REP_B, 1, REP_C, 1, 1, 1, 1, REP_B, REP_B, 1};
__constant__ unsigned char kPhaseLayer[NPH] = {0, 0, 0, 0, 0, 0, 0, 0, 0, 1, 1, 1, 1, 1, 1, 1, 1, 2, 2, 2, 2, 2, 2, 2, 2, 2, 2, 3, 3, 3, 3, 3, 3, 3, 3};
__global__ void __launch_bounds__(512, 2) mega_fwd(P kp) {
    extern __shared__ __attribute__((aligned(16))) unsigned char lds_raw[];
    cg::grid_group grid = cg::this_grid();
    LAS unsigned char* lds = (LAS unsigned char*)lds_raw;
    volatile LAS unsigned* bst = (volatile LAS unsigned*)(lds + LDS_BYTES - 64);
    if (threadIdx.x == 0) { bst[0] = 0u; bst[1] = 0u; }
    __syncthreads();
    const XcdBarrier xbar = xcd_barrier_post((unsigned*)(kp.ws + WS_CTL), bst);
    int rep = 0, nsync = 0;
    for (int ph = kp.ph_lo; ph < kp.ph_hi;) {
        int z = 0; asm volatile("" : "+s"(z));
        const PZ p{kp, z};
        bf16_t* Wb = (bf16_t*)(p.ws() + WS_W);
        bf16_t* HA = (bf16_t*)(p.ws() + WS_HA);
        bf16_t* Yb = (bf16_t*)(p.ws() + WS_Y);
        bf16_t* BIG = (bf16_t*)(p.ws() + WS_BIG);
        bool sync_after = true;
        int tid = threadIdx.x; asm volatile("" : "+v"(tid));
        const int lane = tid & 63, wave = __builtin_amdgcn_readfirstlane(tid >> 6);
        const int kind = kPhaseKind[ph], layer = kPhaseLayer[ph];
#ifndef PHASE_MASK
#define PHASE_MASK 0xFFFFFFFFFFFFull
#endif
#define PM(k) (((PHASE_MASK) >> (k)) & 1ull)
        switch (kind) {
        case 0: if (PM(0)) prep_phase(p, lds, tid, wave, lane); break;
        case 1: if (PM(1)) row_phase(p, layer, 0, wave, lane); break;
        case 2: if (PM(2)) row_phase(p, layer, 1, wave, lane); break;
        case 3: if (PM(3)) row_phase(p, layer, 2, wave, lane); break;
        case 4: if (PM(4)) {
            const size_t wo = layer == 0 ? W_A_WO : layer == 1 ? W_G_WO : layer == 2 ? W_R_WO : W_H_WO;
            EpiP<FPlain> E{{Yb, 1024}}; if (layer == 3) run_gemm_lat(lds, HA, Wb + wo, 1024, 1024, E, tid); else run_gemm(lds, HA, Wb + wo, 1024, 1024, E, tid); } break;
        case 5: if (PM(5)) { EpiP<FRelu2> E{{BIG, 4096}}; if (layer == 3) run_gemm_lat(lds, HA, Wb + W_MLP_IN + (size_t)layer * 4194304, 4096, 1024, E, tid); else run_gemm(lds, HA, Wb + W_MLP_IN + (size_t)layer * 4194304, 4096, 1024, E, tid); } break;
        case 6: if (PM(6)) { EpiP<FPlain> E{{HA, 1024}};     if (layer == 3) run_gemm_lat(lds, BIG, Wb + W_MLP_OUT + (size_t)layer * 4194304, 1024, 4096, E, tid); else { run_gemm(lds, BIG, Wb + W_MLP_OUT + (size_t)layer * 4194304, 1024, 4096, E, tid); prep_filler(p, lds, tid, wave, lane, layer + 1); } } break;
        case 8: if (PM(8)) dx_phase(p, wave, lane); break;
        case 9: if (PM(9)) {
            EpiP<FPlain> E{{BIG, 3072}}; run_gemm(lds, (const bf16_t*)(p.ws() + WS_BIG + BIG_SG), Wb + W_R_GUP, 1024, 256, E, tid); } break;
        case 10: if (PM(10)) { EpiN<FQkv> E{{BIG, (bf16_t*)(p.ws() + WS_BIG + BIG_VT), (const float*)(p.ws() + WS_SMALL)}}; run_gemm(lds, HA, Wb + W_A_QKV, 1536, 1024, E, tid); } break;
        case 11: if (PM(11)) { EpiP<FGlaIn> E{{BIG, (float*)(p.ws() + WS_T), Yb}}; run_gemm(lds, HA, Wb + W_G_WIN, 3328, 1024, E, tid); } break;
        case 12: if (PM(12)) { EpiP<FRwkvIn> E{{BIG, (bf16_t*)(p.ws() + WS_BIG + BIG_LR), (bf16_t*)(p.ws() + WS_BIG + BIG_SG)}}; run_gemm(lds, HA, Wb + W_R_B2, 3584, 2048, E, tid); } break;
        case 13: if (PM(13)) { EpiP<FHgrnIn> E{{BIG, Yb}}; run_gemm(lds, HA, Wb + W_H_WIN, 5120, 1024, E, tid); } break;
        case 20: if (PM(20)) attn_phase(p, lds, tid, wave, lane); break;
        case 21: if (PM(21)) gla_scan_phase(p, lds, tid, wave, lane); break;
        case 22: if (PM(22)) rwkv_chunk_scan_phase(p, lds, wave, lane); break;
        case 23: if (PM(23)) chunk_scan_phase<1>(p, lds, tid, wave, lane); break;
        case 30: if (PM(30)) post_diag_phase<0>(p, wave, lane); break;
        case 31: if (PM(31)) post_rwkv_phase(p, wave, lane); break;
        case 32: if (PM(32)) post_diag_phase<1>(p, wave, lane); break;
        default: break;
        }
        ++rep;
        if (rep < kPhaseRep[ph]) { xcd_barrier(xbar); continue; }
        rep = 0;
        if (ph + 1 < kp.ph_hi) {
            if (!sync_after) __syncthreads();
            else if (nsync++ == 0) grid.sync();
            else xcd_barrier(xbar);
        }
        ++ph;
    }
}

extern "C" void kernel_launch(void* const* d_in, const int* in_sizes, int n_in, void* d_out, int out_size, void* d_ws, size_t ws_size, hipStream_t stream) {
    static int grid = 0;
    if (grid == 0) {
        if (n_in != 42 || ws_size < WS_END) { fprintf(stderr, "kernel_launch: unexpected n_in %d / ws_size %zu (need %zu)\n", n_in, ws_size, (size_t)WS_END); grid = -1; return; }
        int dev = 0, cus = 0, per_cu = 0;
        hipGetDevice(&dev);
        hipDeviceGetAttribute(&cus, hipDeviceAttributeMultiprocessorCount, dev);
        if (hipFuncSetAttribute((const void*)mega_fwd, hipFuncAttributeMaxDynamicSharedMemorySize, LDS_BYTES) != hipSuccess) { fprintf(stderr, "kernel_launch: hipFuncSetAttribute failed\n"); grid = -1; return; }
        if (hipOccupancyMaxActiveBlocksPerMultiprocessor(&per_cu, (const void*)mega_fwd, 512, LDS_BYTES) != hipSuccess || per_cu < 1) { fprintf(stderr, "kernel_launch: occupancy query says %d\n", per_cu); per_cu = 1; }
        (void)hipGetLastError();
        grid = cus * 1;
    }
    if (grid < 0) return;
    if (hipMemsetAsync((char*)d_ws + WS_CTL, 0, XCD_BAR_WORDS * 4, stream) != hipSuccess) { fprintf(stderr, "kernel_launch: memset of the barrier words failed\n"); return; }
    P p{};
    for (int i = 0; i < 42; ++i) p.in[i] = (const float*)d_in[i];
    p.out = (float*)d_out; p.ws = (unsigned char*)d_ws; p.ph_lo = 0; p.ph_hi = NPH;
    void* args[] = {&p};
    hipError_t e = hipLaunchCooperativeKernel((const void*)mega_fwd, dim3(grid), dim3(512), args, LDS_BYTES, stream);
    if (e != hipSuccess) fprintf(stderr, "cooperative launch failed: %s (grid %d)\n", hipGetErrorString(e), grid);
}
```
